# Optimizing an MI355X kernel written in HIP

```python
import jax, jax.numpy as jnp
from jax import lax
import numpy as np

D_MODEL = 1024
BATCH = 8
SEQ = 4096
DEPTH = 1

N_HEADS_ATTN = 8
N_KV_HEADS = 2
GQA_GROUP = N_HEADS_ATTN // N_KV_HEADS
HEAD_DIM = 64
D_ATTN = N_HEADS_ATTN * HEAD_DIM
D_KV = N_KV_HEADS * HEAD_DIM
N_CONV_GROUPS = 8
D_CONV = D_MODEL - D_ATTN
CONV_WIDTH = 3
CMP_BLOCK = 32
CMP_STRIDE = 16
CMP_HIDDEN = 2 * HEAD_DIM
SEL_BLOCK = 64
SEL_TOPK = 16
WINDOW = 512
Q_CHUNK = 64
D_FF = 2816
FFN_CONV_WIDTH = 3
EPS = 1e-6
NEG = -1e30
BIG = 1e30
PROJ_WIDTHS = [D_ATTN] + [D_KV] * 6 + [3 * N_HEADS_ATTN] + [D_CONV] * 3
W_IN_COLS = sum(PROJ_WIDTHS)

kernel_name = "hymba_nsa_shortconv_convffn"


def rmsnorm(x, g):
    xf = x.astype(jnp.float32)
    y = xf * lax.rsqrt(jnp.mean(xf * xf, axis=-1, keepdims=True) + EPS)
    return (y * g.astype(jnp.float32)).astype(x.dtype)


def causal_dwconv(u, w):
    T = u.shape[1]
    W = w.shape[0]
    up = jnp.pad(u, ((0, 0), (W - 1, 0), (0, 0)))
    y = w[0] * up[:, 0:T]
    for k in range(1, W):
        y = y + w[k] * up[:, k:k + T]
    return y


def alibi_slopes(n):
    return jnp.exp2(-8.0 * jnp.arange(1, n + 1, dtype=jnp.float32) / n)


def masked_softmax(s, mask):
    s = jnp.where(mask, s, NEG)
    p = jax.nn.softmax(s, axis=-1)
    return jnp.where(mask, p, 0.0)


def compress_blocks(k, pos, w1, w2):
    B, T, H, dk = k.shape
    n_cmp = (T - CMP_BLOCK) // CMP_STRIDE + 1
    idx = np.arange(n_cmp)[:, None] * CMP_STRIDE + np.arange(CMP_BLOCK)[None, :]
    blk = k[:, idx] + pos[None, None, :, None, :]
    blk = blk.transpose(0, 3, 1, 2, 4).reshape(B, H, n_cmp, CMP_BLOCK * dk)
    return jax.nn.gelu(blk @ w1) @ w2


def cmp_to_sel_map(T):
    n_cmp = (T - CMP_BLOCK) // CMP_STRIDE + 1
    n_sel = T // SEL_BLOCK
    cs = np.arange(n_cmp)[:, None] * CMP_STRIDE
    ss = np.arange(n_sel)[None, :] * SEL_BLOCK
    ov = np.maximum(0, np.minimum(cs + CMP_BLOCK, ss + SEL_BLOCK) - np.maximum(cs, ss))
    return jnp.asarray((ov / CMP_BLOCK).astype(np.float32))


def nsa_attention(q, k_cmp, v_cmp, k_slc, v_slc, k_win, v_win, gates):
    B, H, G, T, dk = q.shape
    n_cmp = k_cmp.shape[2]
    n_sel = T // SEL_BLOCK
    topk = min(SEL_TOPK, n_sel)
    scale = dk ** -0.5
    slopes5 = alibi_slopes(N_HEADS_ATTN).reshape(1, H, G, 1, 1)
    slopes6 = slopes5[..., None]
    cmp_end = jnp.arange(n_cmp) * CMP_STRIDE + (CMP_BLOCK - 1)
    m_sel = cmp_to_sel_map(T)
    k_blocks = k_slc.reshape(B, H, n_sel, SEL_BLOCK, dk)
    v_blocks = v_slc.reshape(B, H, n_sel, SEL_BLOCK, dk)
    k_win_p = jnp.pad(k_win, ((0, 0), (0, 0), (WINDOW, 0), (0, 0)))
    v_win_p = jnp.pad(v_win, ((0, 0), (0, 0), (WINDOW, 0), (0, 0)))
    b_idx = jnp.arange(B)[:, None, None, None]
    h_idx = jnp.arange(H)[None, :, None, None]
    sel_j = jnp.arange(n_sel)

    def chunk(q0):
        t = q0 + jnp.arange(Q_CHUNK)
        qc = lax.dynamic_slice_in_dim(q, q0, Q_CHUNK, axis=3) * scale
        gc = lax.dynamic_slice_in_dim(gates, q0, Q_CHUNK, axis=3)
        d_c = (t[:, None] - cmp_end[None, :]).astype(jnp.float32)
        s_c = jnp.einsum('bkgqd,bknd->bkgqn', qc, k_cmp).astype(jnp.float32) - slopes5 * d_c
        p_c = masked_softmax(s_c, d_c >= 0)
        o_c = jnp.einsum('bkgqn,bknd->bkgqd', p_c.astype(v_cmp.dtype), v_cmp)
        imp = jnp.einsum('bkgqn,nj->bkqj', p_c, m_sel)
        jt = t // SEL_BLOCK
        forced = (sel_j[None, :] == 0) | (sel_j[None, :] == jt[:, None]) | (sel_j[None, :] == jt[:, None] - 1)
        imp = jnp.where(forced, BIG, imp)
        imp = jnp.where(sel_j[None, :] > jt[:, None], NEG, imp)
        _, idx = lax.top_k(imp, topk)
        ks = k_blocks[b_idx, h_idx, idx]
        vs = v_blocks[b_idx, h_idx, idx]
        s_pos = idx[..., None] * SEL_BLOCK + jnp.arange(SEL_BLOCK)
        d_s = (t[None, None, :, None, None] - s_pos).astype(jnp.float32)[:, :, None]
        s_s = jnp.einsum('bkgqd,bkqnsd->bkgqns', qc, ks).astype(jnp.float32) - slopes6 * d_s
        n_tok = topk * SEL_BLOCK
        s_s = s_s.reshape(B, H, G, Q_CHUNK, n_tok)
        p_s = masked_softmax(s_s, (d_s >= 0).reshape(B, H, 1, Q_CHUNK, n_tok))
        o_s = jnp.einsum('bkgqm,bkqmd->bkgqd', p_s.astype(vs.dtype), vs.reshape(B, H, Q_CHUNK, n_tok, dk))
        kw = lax.dynamic_slice_in_dim(k_win_p, q0, Q_CHUNK + WINDOW, axis=2)
        vw = lax.dynamic_slice_in_dim(v_win_p, q0, Q_CHUNK + WINDOW, axis=2)
        w_pos = q0 - WINDOW + jnp.arange(Q_CHUNK + WINDOW)
        d_w = t[:, None] - w_pos[None, :]
        m_w = (d_w >= 0) & (d_w < WINDOW) & (w_pos[None, :] >= 0)
        s_w = jnp.einsum('bkgqd,bkmd->bkgqm', qc, kw).astype(jnp.float32) - slopes5 * d_w.astype(jnp.float32)
        p_w = masked_softmax(s_w, m_w)
        o_w = jnp.einsum('bkgqm,bkmd->bkgqd', p_w.astype(vw.dtype), vw)
        return gc[..., 0:1] * o_c + gc[..., 1:2] * o_s + gc[..., 2:3] * o_w

    starts = jnp.arange(T // Q_CHUNK) * Q_CHUNK
    outs = lax.map(chunk, starts)
    return outs.transpose(1, 0, 4, 2, 3, 5).reshape(B, T, H * G * dk)


def setup_inputs(seed: int = 0) -> dict:
    key = jax.random.key(seed)
    ks = jax.random.split(key, 24)
    nrm = lambda k, shape, s: jax.random.normal(k, shape, jnp.float32) * s
    gain = lambda k, shape: 1.0 + 0.02 * jax.random.normal(k, shape, jnp.float32)
    L = DEPTH
    return {
        "x": nrm(ks[0], (BATCH, SEQ, D_MODEL), 1.0),
        "norm_mix_g": gain(ks[1], (L, D_MODEL)),
        "w_in": nrm(ks[2], (L, D_MODEL, W_IN_COLS), D_MODEL ** -0.5),
        "pos_ck": nrm(ks[3], (L, CMP_BLOCK, HEAD_DIM), 0.1),
        "w_ck1": nrm(ks[4], (L, CMP_BLOCK * HEAD_DIM, CMP_HIDDEN), (CMP_BLOCK * HEAD_DIM) ** -0.5),
        "w_ck2": nrm(ks[5], (L, CMP_HIDDEN, HEAD_DIM), CMP_HIDDEN ** -0.5),
        "pos_cv": nrm(ks[6], (L, CMP_BLOCK, HEAD_DIM), 0.1),
        "w_cv1": nrm(ks[7], (L, CMP_BLOCK * HEAD_DIM, CMP_HIDDEN), (CMP_BLOCK * HEAD_DIM) ** -0.5),
        "w_cv2": nrm(ks[8], (L, CMP_HIDDEN, HEAD_DIM), CMP_HIDDEN ** -0.5),
        "conv_mix_w": nrm(ks[9], (L, CONV_WIDTH, D_CONV), CONV_WIDTH ** -0.5),
        "norm_out_attn_g": gain(ks[10], (L, D_ATTN)),
        "norm_out_conv_g": gain(ks[11], (L, D_CONV)),
        "w_out": nrm(ks[12], (L, D_ATTN + D_CONV, D_MODEL), (D_ATTN + D_CONV) ** -0.5),
        "norm_ffn_g": gain(ks[13], (L, D_MODEL)),
        "w_gate": nrm(ks[14], (L, D_MODEL, D_FF), D_MODEL ** -0.5),
        "w_up": nrm(ks[15], (L, D_MODEL, D_FF), D_MODEL ** -0.5),
        "ffn_conv_w": nrm(ks[16], (L, FFN_CONV_WIDTH, D_FF), FFN_CONV_WIDTH ** -0.5),
        "ffn_conv_b": nrm(ks[17], (L, D_FF), 0.01),
        "w_down": nrm(ks[18], (L, D_FF, D_MODEL), D_FF ** -0.5),
        "norm_final_g": gain(ks[19], (D_MODEL,)),
    }


def reference(x, norm_mix_g, w_in, pos_ck, w_ck1, w_ck2, pos_cv, w_cv1, w_cv2, conv_mix_w,
              norm_out_attn_g, norm_out_conv_g, w_out, norm_ffn_g, w_gate, w_up,
              ffn_conv_w, ffn_conv_b, w_down, norm_final_g):
    B, T, _ = x.shape
    split_at = [int(v) for v in np.cumsum(PROJ_WIDTHS)[:-1]]
    H, G, dk = N_KV_HEADS, GQA_GROUP, HEAD_DIM
    for l in range(DEPTH):
        h = rmsnorm(x, norm_mix_g[l])
        proj = h @ w_in[l]
        q, k_c, v_c, k_s, v_s, k_w, v_w, g_lin, b_g, c_g, u = jnp.split(proj, split_at, axis=-1)
        q = q.reshape(B, T, H, G, dk).transpose(0, 2, 3, 1, 4)
        kv_heads = lambda a: a.reshape(B, T, H, dk)
        k_cmp = compress_blocks(kv_heads(k_c), pos_ck[l], w_ck1[l], w_ck2[l])
        v_cmp = compress_blocks(kv_heads(v_c), pos_cv[l], w_cv1[l], w_cv2[l])
        to_bhtd = lambda a: kv_heads(a).transpose(0, 2, 1, 3)
        gates = jax.nn.sigmoid(g_lin).reshape(B, T, H, G, 3).transpose(0, 2, 3, 1, 4)
        o_attn = nsa_attention(q, k_cmp, v_cmp, to_bhtd(k_s), to_bhtd(v_s),
                               to_bhtd(k_w), to_bhtd(v_w), gates)
        o_conv = b_g * causal_dwconv(c_g * u, conv_mix_w[l])
        mixed = jnp.concatenate([rmsnorm(o_attn, norm_out_attn_g[l]),
                                 rmsnorm(o_conv, norm_out_conv_g[l])], axis=-1)
        x = x + mixed @ w_out[l]
        h2 = rmsnorm(x, norm_ffn_g[l])
        gate = causal_dwconv(h2 @ w_gate[l], ffn_conv_w[l]) + ffn_conv_b[l]
        x = x + (jax.nn.silu(gate) * (h2 @ w_up[l])) @ w_down[l]
    return rmsnorm(x, norm_final_g)
```

```cpp
#include <hip/hip_runtime.h>
#include <hip/hip_cooperative_groups.h>
#include <cstdio>
#include <cstdint>
namespace cg = cooperative_groups;
namespace pg8 {
#define PG8_LAS __attribute__((address_space(3)))
typedef unsigned short bf16_t;
typedef short bf16x8 __attribute__((ext_vector_type(8)));
typedef float f32x4 __attribute__((ext_vector_type(4)));
typedef unsigned u32x4 __attribute__((ext_vector_type(4)));
constexpr int BM = 256, BK = 64, HALF = 128, HTB = HALF * BK * 2  , STAGE_BYTES = 8 * HTB, NXCD = 8, WGM = 8;

__host__ __device__ __forceinline__ int lds_byte(int r, int c) { const int st = (r >> 4) * 2 + (c >> 5), rr = r & 15, cc = c & 31, ob = rr * 64 + cc * 2; return st * 1024 + (ob ^ (((ob >> 9) & 1) << 5)); }
__host__ __device__ __forceinline__ void stage_rc(int b, int& R, int& C) { const int st = b / 1024, sb = b % 1024, swz = sb ^ (((sb >> 9) & 1) << 5); R = (st >> 1) * 16 + swz / 64; C = (st & 1) * 32 + (swz % 64) / 2; }
__host__ __device__ __forceinline__ int perm32(int rho) { const int n = rho >> 4, i = rho & 15; return 8 * (i >> 2) + 4 * n + (i & 3); }

struct Unit { int pm, pn; };
struct Gemm { const bf16_t* A; const bf16_t* Bt; int M, N, K; };

struct StaticOrder {
    int nM, nN, nwg, G, c;
    __host__ __device__ void init(int M, int N, int G_, int c_) { nM = M / BM; nN = N / BM; nwg = nM * nN; G = G_; c = c_; }
    __host__ __device__ bool next(int i, Unit& u) const {
        const long L = (long)i * G + c; if (L >= nwg) return false;
        int wgid = (int)L; { const int q = nwg / NXCD, r = nwg % NXCD, xcd = wgid % NXCD, off = wgid / NXCD; wgid = (xcd < r ? xcd * (q + 1) : r * (q + 1) + (xcd - r) * q) + off; }
        const int nig = WGM * nN, gid = wgid / nig, fm = gid * WGM, gsz = (nM - fm) < WGM ? (nM - fm) : WGM;
        u.pm = fm + ((wgid % nig) % gsz); u.pn = (wgid % nig) / gsz; return true;
    }
    __device__ __forceinline__ void a_ready(const Unit&) const {}
    __device__ __forceinline__ void done(const Unit&) const {}
};

__device__ __forceinline__ unsigned cvt_pk_bf16(float lo, float hi) { unsigned r; asm volatile("v_cvt_pk_bf16_f32 %0, %1, %2" : "=v"(r) : "v"(lo), "v"(hi)); return r; }

struct EpiBf16 {
    static constexpr bool PERM = true, AFTER_DRAIN = false;
    bf16_t* O; int ldc; int split_cols; size_t split_stride;
    __device__ __forceinline__ void operator()(const f32x4 (&acc)[2][2][4][2], const Unit& u, int wr, int wc, int fr, int fq) const {
        const int row0 = u.pm * BM + wr * 64 + fr; int colt = u.pn * BM; bf16_t* base = O;
        if (split_cols) { const int t = colt / split_cols; base += (size_t)t * split_stride; colt -= t * split_cols; }
        const int col0 = colt + wc * 32 + 8 * fq;
#pragma unroll
        for (int ai = 0; ai < 2; ++ai)
#pragma unroll
            for (int m = 0; m < 4; ++m) { bf16_t* rowp = base + (size_t)(row0 + ai * HALF + m * 16) * ldc + col0;
#pragma unroll
                for (int bj = 0; bj < 2; ++bj) { const f32x4 v0 = acc[ai][bj][m][0], v1 = acc[ai][bj][m][1];
                    u32x4 w; w.x = cvt_pk_bf16(v0[0], v0[1]); w.y = cvt_pk_bf16(v0[2], v0[3]); w.z = cvt_pk_bf16(v1[0], v1[1]); w.w = cvt_pk_bf16(v1[2], v1[3]);
                    *(u32x4*)(rowp + bj * HALF) = w; } }
    }
};
struct EpiResF32 {
    static constexpr bool PERM = false, AFTER_DRAIN = false;
    const float* base; float* out; int ldc;
    __device__ __forceinline__ void operator()(const f32x4 (&acc)[2][2][4][2], const Unit& u, int wr, int wc, int fr, int fq) const {
        const int col0 = u.pn * BM + wc * 32 + 4 * fq;
#pragma unroll
        for (int ai = 0; ai < 2; ++ai)
#pragma unroll
            for (int m = 0; m < 4; ++m) { const size_t off = (size_t)(u.pm * BM + ai * HALF + wr * 64 + m * 16 + fr) * ldc + col0;
#pragma unroll
                for (int bj = 0; bj < 2; ++bj)
#pragma unroll
                    for (int n = 0; n < 2; ++n) { const f32x4 bs = *(const f32x4*)(base + off + bj * HALF + n * 16); *(f32x4*)(out + off + bj * HALF + n * 16) = bs + acc[ai][bj][m][n]; } }
    }
};

template <class Epi, class Sched, bool ALIGN_EPI = false, bool SP2 = false>
__device__ __forceinline__ void gemm_phase(PG8_LAS unsigned char* lds, const Gemm g, const Sched& S, const Epi& E) {
    const int tid = threadIdx.x, wid = __builtin_amdgcn_readfirstlane(tid >> 6), lane = tid & 63, wr = wid >> 2, wc = wid & 3, fr = lane & 15, fq = lane >> 4;
    const int K = g.K, nt = K / BK;
    unsigned voffA[2], voffB[2];
#pragma unroll
    for (int i = 0; i < 2; ++i) { int R, C; stage_rc(tid * 16 + i * 8192, R, C); const int Rb = Epi::PERM ? ((R & ~31) + perm32(R & 31)) : R;
        voffA[i] = (unsigned)(R * K + C) * 2u; voffB[i] = (unsigned)(Rb * K + C) * 2u; }
    const size_t kstep = (size_t)(BK * 2);
    const size_t hstep = (size_t)HALF * K * 2;
    const size_t tstep = 2 * hstep;
    const unsigned ldsw = (unsigned)wid * 1024u;
    const int aoff = lds_byte(wr * 64 + fr, fq * 8), boff = lds_byte(wc * 32 + fr, fq * 8);
#define PG8_SA(b, h) (((b) * 2 + (h)) * HTB)
#define PG8_SB(b, h) ((4 + (b) * 2 + (h)) * HTB)
#define PG8_STAGE(bufoff, gbase, voff) do { _Pragma("unroll") for (int _i = 0; _i < 2; ++_i) \
        __builtin_amdgcn_global_load_lds((const unsigned*)((const char*)(gbase) + (voff)[_i]), (PG8_LAS unsigned*)(lds + (bufoff) + ldsw + _i * 8192), 16, 0, 0); } while (0)
#define PG8_LDA(dst, b, h) do { _Pragma("unroll") for (int m = 0; m < 4; ++m) _Pragma("unroll") for (int k = 0; k < 2; ++k) dst[m][k] = *(const PG8_LAS bf16x8*)(lds + PG8_SA(b, h) + aoff + m * 2048 + k * 1024); } while (0)
#define PG8_LDB(dst, b, h) do { _Pragma("unroll") for (int n = 0; n < 2; ++n) _Pragma("unroll") for (int k = 0; k < 2; ++k) dst[n][k] = *(const PG8_LAS bf16x8*)(lds + PG8_SB(b, h) + boff + n * 2048 + k * 1024); } while (0)
#define PG8_MMA(ai, bj, At, Bt) do { __builtin_amdgcn_s_setprio(1); _Pragma("unroll") for (int m = 0; m < 4; ++m) _Pragma("unroll") for (int n = 0; n < 2; ++n) _Pragma("unroll") for (int k = 0; k < 2; ++k) \
        acc[ai][bj][m][n] = __builtin_amdgcn_mfma_f32_16x16x32_bf16(Bt[n][k], At[m][k], acc[ai][bj][m][n], 0, 0, 0); __builtin_amdgcn_s_setprio(0); } while (0)
#define PG8_WAIT_V(n) asm volatile("s_waitcnt vmcnt(" #n ")" ::: "memory")
#define PG8_WAIT_L(n) asm volatile("s_waitcnt lgkmcnt(" #n ")" ::: "memory")
#define PG8_BAR __builtin_amdgcn_s_barrier()
#define PG8_SCHED __builtin_amdgcn_sched_barrier(0)
    Unit cur, nxt; int ui = 0;
    if (!S.next(0, cur)) return;
    f32x4 acc[2][2][4][2];
#pragma unroll
    for (int a = 0; a < 2; ++a)
#pragma unroll
        for (int b = 0; b < 2; ++b)
#pragma unroll
            for (int m = 0; m < 4; ++m)
#pragma unroll
                for (int n = 0; n < 2; ++n) acc[a][b][m][n] = (f32x4){0.f, 0.f, 0.f, 0.f};
    bf16x8 At[4][2], B0[2][2], B1[2][2];
    const char* cA = (const char*)g.A + (size_t)cur.pm * tstep; const char* cB = (const char*)g.Bt + (size_t)cur.pn * tstep;
    S.a_ready(cur);
    if constexpr (SP2) {
        PG8_STAGE(PG8_SB(0, 0), cB, voffB); PG8_STAGE(PG8_SB(0, 1), cB + hstep, voffB); PG8_STAGE(PG8_SA(0, 0), cA, voffA); PG8_STAGE(PG8_SA(0, 1), cA + hstep, voffA);
        if (wr == 1) PG8_BAR;
        PG8_WAIT_V(2); PG8_BAR;
        PG8_STAGE(PG8_SB(1, 0), cB + kstep, voffB); PG8_STAGE(PG8_SA(1, 0), cA + kstep, voffA); PG8_STAGE(PG8_SB(1, 1), cB + hstep + kstep, voffB);
        PG8_WAIT_V(6); PG8_BAR;
    } else {
        PG8_STAGE(PG8_SB(0, 0), cB, voffB); PG8_STAGE(PG8_SA(0, 0), cA, voffA); PG8_STAGE(PG8_SB(0, 1), cB + hstep, voffB); PG8_STAGE(PG8_SA(0, 1), cA + hstep, voffA);
        if (wr == 1) PG8_BAR;
        PG8_WAIT_V(4); PG8_BAR;
        PG8_STAGE(PG8_SB(1, 0), cB + kstep, voffB); PG8_STAGE(PG8_SA(1, 0), cA + kstep, voffA); PG8_STAGE(PG8_SB(1, 1), cB + hstep + kstep, voffB);
        PG8_WAIT_V(6); PG8_BAR;
    }
    for (;;) {
        const bool has_next = S.next(ui + 1, nxt);
        const char* nA = has_next ? (const char*)g.A + (size_t)nxt.pm * tstep : cA; const char* nB = has_next ? (const char*)g.Bt + (size_t)nxt.pn * tstep : cB;
        for (int t = 0; t < nt; t += 2) {
            const bool last = (t == nt - 2);
            const char* a1 = cA + (size_t)(t + 1) * kstep;
            const char* a2 = last ? nA : cA + (size_t)(t + 2) * kstep; const char* b2 = last ? nB : cB + (size_t)(t + 2) * kstep;
            const char* a3 = a2 + kstep; const char* b3 = b2 + kstep;
            if (last && has_next) S.a_ready(nxt);
            if constexpr (SP2) {
            PG8_LDB(B0, 0, 0); PG8_LDB(B1, 0, 1); PG8_SCHED; PG8_LDA(At, 0, 0); PG8_STAGE(PG8_SA(1, 1), a1 + hstep, voffA);
            PG8_WAIT_V(8); PG8_WAIT_L(0); PG8_BAR; PG8_MMA(0, 0, At, B0); PG8_MMA(0, 1, At, B1); PG8_BAR; PG8_SCHED;
            PG8_LDA(At, 0, 1); PG8_STAGE(PG8_SB(0, 0), b2, voffB); PG8_STAGE(PG8_SB(0, 1), b2 + hstep, voffB); PG8_STAGE(PG8_SA(0, 0), a2, voffA);
            PG8_WAIT_V(8); PG8_WAIT_L(0); PG8_BAR; PG8_MMA(1, 0, At, B0); PG8_MMA(1, 1, At, B1); PG8_BAR; PG8_SCHED;
            PG8_LDB(B0, 1, 0); PG8_LDB(B1, 1, 1); PG8_SCHED; PG8_LDA(At, 1, 0); PG8_STAGE(PG8_SA(0, 1), a2 + hstep, voffA);
            PG8_WAIT_V(8); PG8_WAIT_L(0); PG8_BAR; PG8_MMA(0, 0, At, B0); PG8_MMA(0, 1, At, B1); PG8_BAR; PG8_SCHED;
            PG8_LDA(At, 1, 1); PG8_STAGE(PG8_SB(1, 0), b3, voffB); PG8_STAGE(PG8_SB(1, 1), b3 + hstep, voffB); PG8_STAGE(PG8_SA(1, 0), a3, voffA);
            PG8_WAIT_V(8); PG8_WAIT_L(0); PG8_BAR; PG8_MMA(1, 0, At, B0); PG8_MMA(1, 1, At, B1); PG8_BAR; PG8_SCHED;
            } else {
            PG8_LDB(B0, 0, 0); PG8_SCHED; PG8_LDA(At, 0, 0); PG8_STAGE(PG8_SA(1, 1), a1 + hstep, voffA);
            PG8_WAIT_L(8); PG8_BAR; PG8_WAIT_L(0); PG8_MMA(0, 0, At, B0); PG8_BAR; PG8_SCHED;
            PG8_LDB(B1, 0, 1); PG8_STAGE(PG8_SB(0, 0), b2, voffB);
            PG8_BAR; PG8_WAIT_L(0); PG8_MMA(0, 1, At, B1); PG8_BAR;
            PG8_LDA(At, 0, 1); PG8_STAGE(PG8_SA(0, 0), a2, voffA);
            PG8_BAR; PG8_WAIT_L(0); PG8_MMA(1, 0, At, B0); PG8_BAR; PG8_SCHED;
            PG8_STAGE(PG8_SB(0, 1), b2 + hstep, voffB);
            PG8_WAIT_V(6); PG8_BAR; PG8_MMA(1, 1, At, B1); PG8_BAR;
            PG8_LDB(B0, 1, 0); PG8_SCHED; PG8_LDA(At, 1, 0); PG8_STAGE(PG8_SA(0, 1), a2 + hstep, voffA);
            PG8_WAIT_L(8); PG8_BAR; PG8_WAIT_L(0); PG8_MMA(0, 0, At, B0); PG8_BAR; PG8_SCHED;
            PG8_LDB(B1, 1, 1); PG8_STAGE(PG8_SB(1, 0), b3, voffB);
            PG8_BAR; PG8_WAIT_L(0); PG8_MMA(0, 1, At, B1); PG8_BAR;
            PG8_LDA(At, 1, 1); PG8_STAGE(PG8_SA(1, 0), a3, voffA);
            PG8_BAR; PG8_WAIT_L(0); PG8_MMA(1, 0, At, B0); PG8_BAR; PG8_SCHED;
            PG8_STAGE(PG8_SB(1, 1), b3 + hstep, voffB);
            PG8_WAIT_V(6); PG8_BAR; PG8_MMA(1, 1, At, B1); PG8_BAR;
            }
        }
        if constexpr (ALIGN_EPI) { if (wr == 0) PG8_BAR; }
        if constexpr (!Epi::AFTER_DRAIN) { E(acc, cur, wr, wc, fr, fq); S.done(cur); }
        if (!has_next) break;
#pragma unroll
        for (int a = 0; a < 2; ++a)
#pragma unroll
            for (int b = 0; b < 2; ++b)
#pragma unroll
                for (int m = 0; m < 4; ++m)
#pragma unroll
                    for (int n = 0; n < 2; ++n) acc[a][b][m][n] = (f32x4){0.f, 0.f, 0.f, 0.f};
        cur = nxt; cA = nA; cB = nB; ++ui;
        if constexpr (ALIGN_EPI) { if (wr == 1) PG8_BAR; }
    }
    PG8_WAIT_V(0);
    if constexpr (!ALIGN_EPI) { if (wr == 0) PG8_BAR; }
    PG8_BAR;
    if constexpr (Epi::AFTER_DRAIN) { E.fused(acc, cur, wr, wc, fr, fq, lds, wid, lane); S.done(cur); }
#undef PG8_SA
#undef PG8_SB
#undef PG8_STAGE
#undef PG8_LDA
#undef PG8_LDB
#undef PG8_MMA
#undef PG8_WAIT_V
#undef PG8_WAIT_L
#undef PG8_BAR
#undef PG8_SCHED
}
}

#ifndef MK_N_LAUNCHES
#define MK_N_LAUNCHES 1
#endif
constexpr int NWAVES = 8;
constexpr int BATCH = 8, T = 4096, D = 1024, M = BATCH * T;
constexpr int NPROJ = 2840, NP = 3072;
constexpr int DFF = 2816, NGU = 2 * DFF;
constexpr int COL_Q = 0, COL_KC = 512, COL_VC = 640, COL_KS = 768, COL_VS = 896, COL_KW = 1024, COL_VW = 1152, COL_G = 1280, COL_BG = 1304, COL_CG = 1816, COL_U = 2328;
constexpr float EPS = 1e-6f;
constexpr float LOG2E = 1.4426950408889634f;

constexpr size_t MiB = 1u << 20;
constexpr size_t WS_CTL = 0;
constexpr size_t WS_WIN = 2 * MiB, WS_WOUT = 8 * MiB, WS_WGU = 10 * MiB, WS_WDN = 21 * MiB;
constexpr size_t WS_WC1K = 27 * MiB, WS_WC1V = 27 * MiB + 512 * 1024;
constexpr size_t WS_KCMP = 28 * MiB, WS_VCMPT = 28 * MiB + 512 * 1024, WS_SSA = 29 * MiB;
constexpr size_t WS_XN = 32 * MiB, WS_MIX = 96 * MiB, WS_P = 160 * MiB;
constexpr size_t WS_VTS = 352 * MiB, WS_VTW = 360 * MiB, WS_OATT = 368 * MiB;
constexpr size_t WS_GP = 160 * MiB, WS_UP = 336 * MiB, WS_END = 512 * MiB;
static_assert(WS_P + (size_t)M * NP * 2 <= WS_VTS && WS_GP + (size_t)M * DFF * 2 <= WS_UP && WS_UP + (size_t)M * DFF * 2 <= WS_END, "ws map");

constexpr int RING_BYTES = 131072;
constexpr int LDS_BYTES = 147456;

#define LAS __attribute__((address_space(3)))
typedef unsigned short bf16;
typedef unsigned u32x4 __attribute__((ext_vector_type(4)));
typedef unsigned u32x2 __attribute__((ext_vector_type(2)));
typedef float f32x4 __attribute__((ext_vector_type(4)));
typedef float f32x2 __attribute__((ext_vector_type(2)));
typedef short bf16x8 __attribute__((ext_vector_type(8)));
typedef short s16x4 __attribute__((ext_vector_type(4)));
typedef __bf16 bf16x2_t __attribute__((ext_vector_type(2)));

__device__ __forceinline__ unsigned pk2(float lo, float hi) { f32x2 v = {lo, hi}; bf16x2_t b = __builtin_convertvector(v, bf16x2_t); return __builtin_bit_cast(unsigned, b); }
__device__ __forceinline__ float bf_lo(unsigned u) { return __uint_as_float(u << 16); }
__device__ __forceinline__ float bf_hi(unsigned u) { return __uint_as_float(u & 0xffff0000u); }
__device__ __forceinline__ float bf1(bf16 u) { return __uint_as_float((unsigned)u << 16); }
__device__ __forceinline__ float wave_sum(float v) {
#pragma unroll
    for (int o = 1; o < 64; o <<= 1) v += __shfl_xor(v, o);
    return v;
}
__device__ __forceinline__ float sigmoidf_(float x) { return 1.0f / (1.0f + __expf(-x)); }

struct Args { const float* in[20]; float* out; unsigned char* ws; int ph_lo, ph_hi; };

__device__ __forceinline__ void p0_transpose_item(const float* W, int K, int Nsrc, bf16* WT, int row_off, LAS float* scr, int item, int nblk, int lane) {
    const int kb = item / nblk, nb = item % nblk, k0 = 64 * kb, n0 = 32 * nb;
    const int n = n0 + (lane & 31);
#pragma unroll 8
    for (int i = 0; i < 32; ++i) { const int kk = 2 * i + (lane >> 5); scr[kk * 33 + (lane & 31)] = (n < Nsrc) ? W[(size_t)(k0 + kk) * Nsrc + n] : 0.f; }
    asm volatile("s_waitcnt lgkmcnt(0)" ::: "memory");
    const int c = lane & 7;
#pragma unroll
    for (int j = 0; j < 4; ++j) { const int nn = (lane >> 3) + 8 * j; const LAS float* s = scr + (8 * c) * 33 + nn;
        u32x4 o; o.x = pk2(s[0 * 33], s[1 * 33]); o.y = pk2(s[2 * 33], s[3 * 33]); o.z = pk2(s[4 * 33], s[5 * 33]); o.w = pk2(s[6 * 33], s[7 * 33]);
        *(u32x4*)(WT + (size_t)(row_off + n0 + nn) * K + k0 + 8 * c) = o; }
    asm volatile("s_waitcnt lgkmcnt(0)" ::: "memory");
}
__device__ __forceinline__ void rms_row_bf16(const float* xrow, const float* g, bf16* orow, int lane) {
    const f32x4* xr = (const f32x4*)xrow + lane; const f32x4* gr = (const f32x4*)g + lane;
    f32x4 v[4]; float s = 0.f;
#pragma unroll
    for (int j = 0; j < 4; ++j) { v[j] = xr[64 * j]; s += (v[j].x * v[j].x + v[j].y * v[j].y) + (v[j].z * v[j].z + v[j].w * v[j].w); }
    const float rs = 1.0f / sqrtf(wave_sum(s) * (1.f / D) + EPS);
    u32x2* o8 = (u32x2*)orow + lane;
#pragma unroll
    for (int j = 0; j < 4; ++j) { const f32x4 gg = gr[64 * j]; u32x2 o; o.x = pk2(v[j].x * rs * gg.x, v[j].y * rs * gg.y); o.y = pk2(v[j].z * rs * gg.z, v[j].w * rs * gg.w); o8[64 * j] = o; }
}

__device__ __forceinline__ float gelu_tanh(float x) { const float u = 0.7978845608028654f * (x + 0.044715f * x * x * x); return 0.5f * x * (1.0f + tanhf(u)); }

__device__ __forceinline__ void compress_item(const Args& a, LAS unsigned char* lds, int item, int tid) {
    const int lane = tid & 63, w = __builtin_amdgcn_readfirstlane(tid >> 6), r16 = lane & 15, kq = lane >> 4;
    const int kv = item >> 7, b = (item >> 4) & 7, h = (item >> 3) & 1, ib = item & 7;
    unsigned char* ws = a.ws;
    const bf16* P = (const bf16*)(ws + WS_P);
    const bf16* W1T = (const bf16*)(ws + (kv ? WS_WC1V : WS_WC1K));
    const float* pos = a.in[kv ? 6 : 3];
    const float* w1 = a.in[kv ? 7 : 4];
    const float* w2 = a.in[kv ? 8 : 5];
    LAS unsigned char* Al = lds;
    LAS float* hid = (LAS float*)(lds + 67584);
    LAS float* bpart = (LAS float*)(lds + 67584 + 16512);
    const int col0 = (kv ? COL_VC : COL_KC) + h * 64;
    for (int idx = tid; idx < 528 * 8; idx += 512) {
        const int tau = idx >> 3, c = idx & 7; int tok = 512 * ib + tau; tok = tok < T ? tok : T - 1;
        const u32x4 v = *(const u32x4*)(P + (size_t)(b * T + tok) * NP + col0 + 8 * c);
        *(LAS u32x4*)(Al + tau * 128 + ((c ^ ((tau >> 4) & 7)) << 4)) = v;
    }
    {
        const int n = tid & 127, part = tid >> 7; float s = 0.f;
#pragma unroll 8
        for (int k = 0; k < 512; ++k) { const int kk = part * 512 + k; s += pos[kk] * w1[(size_t)kk * 128 + n]; }
        bpart[part * 128 + n] = s;
    }
    __syncthreads();
    f32x4 acc0 = {0.f, 0.f, 0.f, 0.f}, acc1 = {0.f, 0.f, 0.f, 0.f};
    const bf16* wrow = W1T + (size_t)(16 * w + r16) * 2048 + 8 * kq;
#pragma unroll 8
    for (int s = 0; s < 64; ++s) {
        const bf16x8 af = *(const bf16x8*)(wrow + 32 * s);
        const int l = s >> 1, c = (s & 1) * 4 + kq;
        const int tau0 = 16 * r16 + l, tau1 = tau0 + 256;
        const bf16x8 b0 = *(const LAS bf16x8*)(Al + tau0 * 128 + ((c ^ ((tau0 >> 4) & 7)) << 4));
        const bf16x8 b1 = *(const LAS bf16x8*)(Al + tau1 * 128 + ((c ^ ((tau1 >> 4) & 7)) << 4));
        acc0 = __builtin_amdgcn_mfma_f32_16x16x32_bf16(af, b0, acc0, 0, 0, 0);
        acc1 = __builtin_amdgcn_mfma_f32_16x16x32_bf16(af, b1, acc1, 0, 0, 0);
    }
#pragma unroll
    for (int j = 0; j < 4; ++j) { const int n = 16 * w + 4 * kq + j; const float bs = (bpart[n] + bpart[128 + n]) + (bpart[256 + n] + bpart[384 + n]);
        hid[r16 * 129 + n] = gelu_tanh(acc0[j] + bs); hid[(16 + r16) * 129 + n] = gelu_tanh(acc1[j] + bs); }
    __syncthreads();
    {
        const int i = tid >> 4, d4 = (tid & 15) * 4; f32x4 o = {0.f, 0.f, 0.f, 0.f};
#pragma unroll 8
        for (int n = 0; n < 128; ++n) { const float hv = hid[i * 129 + n]; const f32x4 wv = *(const f32x4*)(w2 + n * 64 + d4); o += hv * wv; }
        const int ig = 32 * ib + i;
        if (ig == 255) o = (f32x4){0.f, 0.f, 0.f, 0.f};
        if (kv == 0) { bf16* K = (bf16*)(ws + WS_KCMP); u32x2 pk; pk.x = pk2(o.x, o.y); pk.y = pk2(o.z, o.w); *(u32x2*)(K + ((size_t)(b * 2 + h) * 256 + ig) * 64 + d4) = pk; }
        else { bf16* Vt = (bf16*)(ws + WS_VCMPT);
#pragma unroll
            for (int e = 0; e < 4; ++e) Vt[((size_t)(b * 2 + h) * 64 + d4 + e) * 256 + ig] = (bf16)(pk2(o[e], 0.f) & 0xffffu); }
    }
    __syncthreads();
}

__device__ __forceinline__ void vtrans_item(const Args& a, LAS unsigned char* lds, int item, int tid) {
    const int which = item >> 10, b = (item >> 7) & 7, hk = (item >> 6) & 1, tt = item & 63;
    const bf16* P = (const bf16*)(a.ws + WS_P);
    bf16* VT = (bf16*)(a.ws + (which ? WS_VTW : WS_VTS));
    const int r = tid >> 3, c = tid & 7;
    const u32x4 v = *(const u32x4*)(P + (size_t)(b * T + 64 * tt + r) * NP + (which ? COL_VW : COL_VS) + hk * 64 + 8 * c);
    *(LAS u32x4*)(lds + r * 144 + c * 16) = v;
    __syncthreads();
    const int d = tid >> 3;
    unsigned short e[8];
#pragma unroll
    for (int j = 0; j < 8; ++j) e[j] = *(const LAS unsigned short*)(lds + (8 * c + j) * 144 + d * 2);
    u32x4 o; o.x = e[0] | ((unsigned)e[1] << 16); o.y = e[2] | ((unsigned)e[3] << 16); o.z = e[4] | ((unsigned)e[5] << 16); o.w = e[6] | ((unsigned)e[7] << 16);
    *(u32x4*)(VT + ((size_t)(b * 2 + hk) * 64 + d) * T + 64 * tt + 8 * c) = o;
    __syncthreads();
}

__device__ __forceinline__ void conv_row(const Args& a, int m, int lane) {
    const bf16* P = (const bf16*)(a.ws + WS_P); bf16* MIX = (bf16*)(a.ws + WS_MIX);
    const float* cw = a.in[9]; const float* gn = a.in[11];
    const int t = m & (T - 1), ch = 8 * lane;
    const bf16* row = P + (size_t)m * NP;
    float y[8];
#pragma unroll
    for (int e = 0; e < 8; ++e) y[e] = 0.f;
#pragma unroll
    for (int k = 0; k < 3; ++k) {
        const int dt = 2 - k;
        if (t - dt >= 0) {
            const u32x4 cv = *(const u32x4*)(row - (size_t)dt * NP + COL_CG + ch), uv = *(const u32x4*)(row - (size_t)dt * NP + COL_U + ch);
            const f32x4 w0 = *(const f32x4*)(cw + k * 512 + ch), w1 = *(const f32x4*)(cw + k * 512 + ch + 4);
            y[0] += w0.x * bf_lo(cv.x) * bf_lo(uv.x); y[1] += w0.y * bf_hi(cv.x) * bf_hi(uv.x);
            y[2] += w0.z * bf_lo(cv.y) * bf_lo(uv.y); y[3] += w0.w * bf_hi(cv.y) * bf_hi(uv.y);
            y[4] += w1.x * bf_lo(cv.z) * bf_lo(uv.z); y[5] += w1.y * bf_hi(cv.z) * bf_hi(uv.z);
            y[6] += w1.z * bf_lo(cv.w) * bf_lo(uv.w); y[7] += w1.w * bf_hi(cv.w) * bf_hi(uv.w);
        }
    }
    const u32x4 bv = *(const u32x4*)(row + COL_BG + ch);
    y[0] *= bf_lo(bv.x); y[1] *= bf_hi(bv.x); y[2] *= bf_lo(bv.y); y[3] *= bf_hi(bv.y); y[4] *= bf_lo(bv.z); y[5] *= bf_hi(bv.z); y[6] *= bf_lo(bv.w); y[7] *= bf_hi(bv.w);
    float s = 0.f;
#pragma unroll
    for (int e = 0; e < 8; ++e) s += y[e] * y[e];
    const float rs = 1.0f / sqrtf(wave_sum(s) * (1.f / 512.f) + EPS);
    const f32x4 g0 = *(const f32x4*)(gn + ch), g1 = *(const f32x4*)(gn + ch + 4);
    u32x4 o; o.x = pk2(y[0] * rs * g0.x, y[1] * rs * g0.y); o.y = pk2(y[2] * rs * g0.z, y[3] * rs * g0.w); o.z = pk2(y[4] * rs * g1.x, y[5] * rs * g1.y); o.w = pk2(y[6] * rs * g1.z, y[7] * rs * g1.w);
    *(u32x4*)(MIX + (size_t)m * D + 512 + ch) = o;
}

constexpr int AL_K0 = 0, AL_V0 = 18432, AL_IMP = 36864, AL_SELM = 54272, AL_WUN = 54784, AL_CTL = 54848;
constexpr int TPITCH = 144;
constexpr int IMPP = 68;

struct TileRegs { u32x4 k, v; };
__device__ __forceinline__ TileRegs tile_load(const bf16* kb, size_t kp, const bf16* vb, size_t vp, int tid) {
    const int r = tid >> 3, c = tid & 7; TileRegs t;
    t.k = *(const u32x4*)(kb + (size_t)r * kp + 8 * c); t.v = *(const u32x4*)(vb + (size_t)r * vp + 8 * c); return t;
}
__device__ __forceinline__ void tile_store(LAS unsigned char* lds, int buf, const TileRegs& t, int tid) {
    const int r = tid >> 3, c = tid & 7;
    *(LAS u32x4*)(lds + AL_K0 + buf * 9216 + r * TPITCH + c * 16) = t.k;
    *(LAS u32x4*)(lds + AL_V0 + buf * 9216 + r * TPITCH + c * 16) = t.v;
}

template <int MODE>
__device__ __forceinline__ void tile_compute(LAS unsigned char* lds, int buf, int pos0, int t, const bf16x8 (&Qf)[2][2], const float (&sl2)[2],
                                             float (&mrow)[2], float (&lrow)[2], f32x4 (&O)[2][4], bool selbit, LAS float* improw, int impj0, int lane) {
    const int r16 = lane & 15, kq = lane >> 4;
    const LAS unsigned char* Kb = lds + AL_K0 + buf * 9216; const LAS unsigned char* Vb = lds + AL_V0 + buf * 9216;
    f32x4 st[2][4];
#pragma unroll
    for (int qb = 0; qb < 2; ++qb)
#pragma unroll
        for (int kb = 0; kb < 4; ++kb) st[qb][kb] = (f32x4){0.f, 0.f, 0.f, 0.f};
#pragma unroll
    for (int kb = 0; kb < 4; ++kb)
#pragma unroll
        for (int ks = 0; ks < 2; ++ks) { const bf16x8 kf = *(const LAS bf16x8*)(Kb + (16 * kb + r16) * TPITCH + (32 * ks + 8 * kq) * 2);
#pragma unroll
            for (int qb = 0; qb < 2; ++qb) st[qb][kb] = __builtin_amdgcn_mfma_f32_16x16x32_bf16(kf, Qf[qb][ks], st[qb][kb], 0, 0, 0); }
    const float sc = 0.125f * LOG2E;
    float tmax[2] = {-1e30f, -1e30f};
    bool valid[4][4];
#pragma unroll
    for (int kb = 0; kb < 4; ++kb)
#pragma unroll
        for (int j = 0; j < 4; ++j) {
            const int kidx = 16 * kb + 4 * kq + j; int dist;
            if (MODE <= 1) dist = t - (16 * (pos0 + kidx) + 31); else dist = t - (pos0 + kidx);
            bool v = dist >= 0;
            if (MODE == 2) v = v && selbit;
            if (MODE == 3) v = v && (dist < 512);
            valid[kb][j] = v; const float fd = (float)dist;
#pragma unroll
            for (int qb = 0; qb < 2; ++qb) { float s = st[qb][kb][j] * sc - sl2[qb] * fd; s = v ? s : -1e30f; st[qb][kb][j] = s; tmax[qb] = fmaxf(tmax[qb], s); }
        }
    float mnew[2], alpha[2];
#pragma unroll
    for (int qb = 0; qb < 2; ++qb) {
        if (MODE == 1) { mnew[qb] = mrow[qb]; alpha[qb] = 1.f; }
        else { float tm = tmax[qb]; tm = fmaxf(tm, __shfl_xor(tm, 16)); tm = fmaxf(tm, __shfl_xor(tm, 32)); mnew[qb] = fmaxf(mrow[qb], tm); alpha[qb] = __builtin_amdgcn_exp2f(mrow[qb] - mnew[qb]); mrow[qb] = mnew[qb]; }
    }
#pragma unroll
    for (int qb = 0; qb < 2; ++qb) {
        float ps = 0.f;
#pragma unroll
        for (int kb = 0; kb < 4; ++kb)
#pragma unroll
            for (int j = 0; j < 4; ++j) { float p = valid[kb][j] ? __builtin_amdgcn_exp2f(st[qb][kb][j] - mnew[qb]) : 0.f; if (MODE == 1) p *= lrow[qb]; st[qb][kb][j] = p; ps += p; }
        if (MODE != 1) lrow[qb] = lrow[qb] * alpha[qb] + ps;
    }
    if (MODE == 0) return;
    if (MODE == 1) {
#pragma unroll
        for (int kb = 0; kb < 4; ++kb) {
            float vm = (st[0][kb][0] + st[0][kb][1]) + (st[0][kb][2] + 0.5f * st[0][kb][3]) + (st[1][kb][0] + st[1][kb][1]) + (st[1][kb][2] + 0.5f * st[1][kb][3]);
            float vh = 0.5f * st[0][kb][3] + 0.5f * st[1][kb][3];
            vm += __shfl_xor(vm, 8); vh += __shfl_xor(vh, 8);
            const int jj = impj0 + 4 * kb + kq;
            if ((lane & 8) == 0) { improw[jj] += vm; }
            if ((lane & 8) == 0) { improw[jj + 1] += vh; }
        }
    }
    if (MODE >= 2) {
#pragma unroll
        for (int qb = 0; qb < 2; ++qb)
#pragma unroll
            for (int db = 0; db < 4; ++db) O[qb][db] *= alpha[qb];
    }
    bf16x8 Pf[2][2];
#pragma unroll
    for (int qb = 0; qb < 2; ++qb)
#pragma unroll
        for (int s2 = 0; s2 < 2; ++s2) { u32x4 w; w.x = pk2(st[qb][2 * s2][0], st[qb][2 * s2][1]); w.y = pk2(st[qb][2 * s2][2], st[qb][2 * s2][3]);
            w.z = pk2(st[qb][2 * s2 + 1][0], st[qb][2 * s2 + 1][1]); w.w = pk2(st[qb][2 * s2 + 1][2], st[qb][2 * s2 + 1][3]); Pf[qb][s2] = __builtin_bit_cast(bf16x8, w); }
#pragma unroll
    for (int db = 0; db < 4; ++db)
#pragma unroll
        for (int s2 = 0; s2 < 2; ++s2) {
            const u32x2 lo = *(const LAS u32x2*)(Vb + (16 * db + r16) * TPITCH + (32 * s2 + 4 * kq) * 2);
            const u32x2 hi = *(const LAS u32x2*)(Vb + (16 * db + r16) * TPITCH + (32 * s2 + 16 + 4 * kq) * 2);
            u32x4 w; w.x = lo.x; w.y = lo.y; w.z = hi.x; w.w = hi.y; const bf16x8 vf = __builtin_bit_cast(bf16x8, w);
#pragma unroll
            for (int qb = 0; qb < 2; ++qb) O[qb][db] = __builtin_amdgcn_mfma_f32_16x16x32_bf16(vf, Pf[qb][s2], O[qb][db], 0, 0, 0);
        }
}

__device__ __forceinline__ void attn_item(const Args& a, LAS unsigned char* lds, int it, int tid) {
    const int lane = tid & 63, w = __builtin_amdgcn_readfirstlane(tid >> 6), r16 = lane & 15, kq = lane >> 4, tql = r16 & 7, gl = r16 >> 3;
    const int c = 63 - (it >> 4), b = (it >> 1) & 7, hk = it & 1;
    unsigned char* ws = a.ws;
    const bf16* P = (const bf16*)(ws + WS_P);
    const bf16* KC = (const bf16*)(ws + WS_KCMP) + (size_t)(b * 2 + hk) * 256 * 64;
    const bf16* VCT = (const bf16*)(ws + WS_VCMPT) + (size_t)(b * 2 + hk) * 64 * 256;
    const bf16* VTS = (const bf16*)(ws + WS_VTS) + (size_t)(b * 2 + hk) * 64 * T;
    const bf16* VTW = (const bf16*)(ws + WS_VTW) + (size_t)(b * 2 + hk) * 64 * T;
    const bf16* PKS = P + (size_t)b * T * NP + COL_KS + hk * 64;
    const bf16* PKW = P + (size_t)b * T * NP + COL_KW + hk * 64;
    const int tq = 8 * w + tql, t = 64 * c + tq; const size_t R = (size_t)b * T + t;
    LAS float* imp = (LAS float*)(lds + AL_IMP); LAS unsigned* selm = (LAS unsigned*)(lds + AL_SELM); LAS unsigned* wunl = (LAS unsigned*)(lds + AL_WUN);
    LAS float* improw = imp + tq * IMPP;

    bf16x8 Qf[2][2]; float sl2[2];
#pragma unroll
    for (int qb = 0; qb < 2; ++qb) { const int hq = hk * 4 + 2 * qb + gl; sl2[qb] = LOG2E * exp2f(-(float)(hq + 1));
#pragma unroll
        for (int ks = 0; ks < 2; ++ks) Qf[qb][ks] = *(const bf16x8*)(P + R * NP + COL_Q + hq * 64 + 32 * ks + 8 * kq); }
    float gate[2][3];
#pragma unroll
    for (int qb = 0; qb < 2; ++qb)
#pragma unroll
        for (int br = 0; br < 3; ++br) gate[qb][br] = sigmoidf_(bf1(P[R * NP + COL_G + hk * 12 + (2 * qb + gl) * 3 + br]));
    for (int i = lane; i < 8 * IMPP; i += 64) imp[(8 * w) * IMPP + i] = 0.f;

    f32x4 out[2][4], O[2][4];
#pragma unroll
    for (int qb = 0; qb < 2; ++qb)
#pragma unroll
        for (int db = 0; db < 4; ++db) { out[qb][db] = (f32x4){0.f, 0.f, 0.f, 0.f}; O[qb][db] = (f32x4){0.f, 0.f, 0.f, 0.f}; }
    float mrow[2] = {-1e30f, -1e30f}, lrow[2] = {0.f, 0.f};
    int buf = 0;
    TileRegs tr;

    const int nct = (4 * c + 3 + 63) >> 6;
    tr = tile_load(KC, 64, VCT, 256, tid);
    for (int ti = 0; ti < nct; ++ti) {
        tile_store(lds, buf, tr, tid); __syncthreads();
        { const int nx = (ti + 1 < nct) ? ti + 1 : 0; tr = tile_load(KC + (size_t)nx * 64 * 64, 64, VCT + nx * 64, 256, tid); }
        tile_compute<0>(lds, buf, 64 * ti, t, Qf, sl2, mrow, lrow, O, true, improw, 0, lane);
        buf ^= 1;
    }
#pragma unroll
    for (int qb = 0; qb < 2; ++qb) { float l = lrow[qb]; l += __shfl_xor(l, 16); l += __shfl_xor(l, 32); lrow[qb] = l > 0.f ? 1.0f / l : 0.f; }
    for (int ti = 0; ti < nct; ++ti) {
        tile_store(lds, buf, tr, tid); __syncthreads();
        if (ti + 1 < nct) tr = tile_load(KC + (size_t)(ti + 1) * 64 * 64, 64, VCT + (ti + 1) * 64, 256, tid);
        tile_compute<1>(lds, buf, 64 * ti, t, Qf, sl2, mrow, lrow, O, true, improw, 16 * ti, lane);
        buf ^= 1;
    }
#pragma unroll
    for (int qb = 0; qb < 2; ++qb)
#pragma unroll
        for (int db = 0; db < 4; ++db) { out[qb][db] = gate[qb][0] * O[qb][db]; O[qb][db] = (f32x4){0.f, 0.f, 0.f, 0.f}; }

    unsigned long long wun = 0ull;
    for (int tt = 0; tt < 8; ++tt) {
        LAS float* row = imp + (8 * w + tt) * IMPP;
        float mine = row[lane];
        if (lane == 0 || lane == c || lane == c - 1) mine = 1e30f;
        if (lane > c) mine = -1e30f;
        row[lane] = mine;
        int rank = 0;
#pragma unroll
        for (int i4 = 0; i4 < 16; ++i4) { const f32x4 v = *(const LAS f32x4*)(row + 4 * i4);
#pragma unroll
            for (int e = 0; e < 4; ++e) { const int i = 4 * i4 + e; rank += ((v[e] > mine) || (v[e] == mine && i < lane)) ? 1 : 0; } }
        const bool sel = (rank < 16) && (lane <= c);
        const unsigned long long mk = __ballot(sel);
        wun |= mk;
        if (lane == 0) { selm[(8 * w + tt) * 2] = (unsigned)mk; selm[(8 * w + tt) * 2 + 1] = (unsigned)(mk >> 32); }
    }
    if (lane == 0) { wunl[2 * w] = (unsigned)wun; wunl[2 * w + 1] = (unsigned)(wun >> 32); }
    const unsigned long long mysel = (unsigned long long)selm[tq * 2] | ((unsigned long long)selm[tq * 2 + 1] << 32);
    __syncthreads();
    unsigned long long uni = 0ull;
#pragma unroll
    for (int i = 0; i < 8; ++i) uni |= (unsigned long long)wunl[2 * i] | ((unsigned long long)wunl[2 * i + 1] << 32);
    uni = ((unsigned long long)__builtin_amdgcn_readfirstlane((unsigned)(uni >> 32)) << 32) | (unsigned long long)__builtin_amdgcn_readfirstlane((unsigned)uni);

    mrow[0] = mrow[1] = -1e30f; lrow[0] = lrow[1] = 0.f;
    {
        int j = __builtin_ctzll(uni);
        tr = tile_load(PKS + (size_t)(64 * j) * NP, NP, VTS + 64 * j, T, tid);
        while (uni) {
            j = __builtin_ctzll(uni); uni &= uni - 1;
            tile_store(lds, buf, tr, tid); __syncthreads();
            if (uni) { const int jn = __builtin_ctzll(uni); tr = tile_load(PKS + (size_t)(64 * jn) * NP, NP, VTS + 64 * jn, T, tid); }
            if ((wun >> j) & 1ull) tile_compute<2>(lds, buf, 64 * j, t, Qf, sl2, mrow, lrow, O, ((mysel >> j) & 1ull) != 0ull, improw, 0, lane);
            buf ^= 1;
        }
    }
#pragma unroll
    for (int qb = 0; qb < 2; ++qb) { float l = lrow[qb]; l += __shfl_xor(l, 16); l += __shfl_xor(l, 32); const float inv = (l > 0.f ? 1.0f / l : 0.f) * gate[qb][1];
#pragma unroll
        for (int db = 0; db < 4; ++db) { out[qb][db] += inv * O[qb][db]; O[qb][db] = (f32x4){0.f, 0.f, 0.f, 0.f}; } }

    mrow[0] = mrow[1] = -1e30f; lrow[0] = lrow[1] = 0.f;
    {
        const int j0 = c >= 8 ? c - 8 : 0;
        tr = tile_load(PKW + (size_t)(64 * j0) * NP, NP, VTW + 64 * j0, T, tid);
        for (int j = j0; j <= c; ++j) {
            tile_store(lds, buf, tr, tid); __syncthreads();
            if (j < c) tr = tile_load(PKW + (size_t)(64 * (j + 1)) * NP, NP, VTW + 64 * (j + 1), T, tid);
            tile_compute<3>(lds, buf, 64 * j, t, Qf, sl2, mrow, lrow, O, true, improw, 0, lane);
            buf ^= 1;
        }
    }
    float ss = 0.f;
    bf16* OA = (bf16*)(ws + WS_OATT);
#pragma unroll
    for (int qb = 0; qb < 2; ++qb) { float l = lrow[qb]; l += __shfl_xor(l, 16); l += __shfl_xor(l, 32); const float inv = (l > 0.f ? 1.0f / l : 0.f) * gate[qb][2];
#pragma unroll
        for (int db = 0; db < 4; ++db) { const f32x4 o = out[qb][db] + inv * O[qb][db]; ss += (o.x * o.x + o.y * o.y) + (o.z * o.z + o.w * o.w);
            u32x2 pk; pk.x = pk2(o.x, o.y); pk.y = pk2(o.z, o.w);
            *(u32x2*)(OA + R * 512 + hk * 256 + (2 * qb + gl) * 64 + 16 * db + 4 * kq) = pk; } }
    ss += __shfl_xor(ss, 8); ss += __shfl_xor(ss, 16); ss += __shfl_xor(ss, 32);
    if (lane < 8) ((float*)(ws + WS_SSA))[R * 2 + hk] = ss;
    __syncthreads();
}

constexpr int NPHASE = 11;
__global__ void __launch_bounds__(NWAVES * 64, 2) hymba_fwd(Args args) {
    extern __shared__ __attribute__((aligned(16))) unsigned char lds_raw[];
    LAS unsigned char* lds = (LAS unsigned char*)lds_raw;
    cg::grid_group grid = cg::this_grid();
    const int tid = threadIdx.x, lane = tid & 63, wave = __builtin_amdgcn_readfirstlane(tid >> 6);
    const int G = gridDim.x, bx = blockIdx.x;
    const int gw = bx * NWAVES + wave, NGW = G * NWAVES;
    unsigned char* ws = args.ws;
    const int lo = args.ph_lo, hi = args.ph_hi;
#define IN(k) (lo <= (k) && (k) < hi)
#define SEAM(k) do { if (IN(k) && IN((k) + 1)) grid.sync(); } while (0)

    if (IN(0)) {
        if (bx == 0 && tid == 0) ((unsigned*)(ws + WS_CTL))[0] = 0u;
        LAS float* scr = (LAS float*)(lds + wave * 16384);
        constexpr int I_IN = 16 * 96, I_OUT = 16 * 32, I_G = 16 * 88, I_DN = 44 * 32, I_C1 = 32 * 4;
        constexpr int NITEMS = I_IN + I_OUT + 2 * I_G + I_DN + 2 * I_C1;
        for (int it = gw; it < NITEMS; it += NGW) {
            int r = it;
            if (r < I_IN) { p0_transpose_item(args.in[2], D, NPROJ, (bf16*)(ws + WS_WIN), 0, scr, r, 96, lane); continue; } r -= I_IN;
            if (r < I_OUT) { p0_transpose_item(args.in[12], D, D, (bf16*)(ws + WS_WOUT), 0, scr, r, 32, lane); continue; } r -= I_OUT;
            if (r < I_G) { p0_transpose_item(args.in[14], D, DFF, (bf16*)(ws + WS_WGU), 0, scr, r, 88, lane); continue; } r -= I_G;
            if (r < I_G) { p0_transpose_item(args.in[15], D, DFF, (bf16*)(ws + WS_WGU), DFF, scr, r, 88, lane); continue; } r -= I_G;
            if (r < I_DN) { p0_transpose_item(args.in[18], DFF, D, (bf16*)(ws + WS_WDN), 0, scr, r, 32, lane); continue; } r -= I_DN;
            if (r < I_C1) { p0_transpose_item(args.in[4], 2048, 128, (bf16*)(ws + WS_WC1K), 0, scr, r, 4, lane); continue; } r -= I_C1;
            p0_transpose_item(args.in[7], 2048, 128, (bf16*)(ws + WS_WC1V), 0, scr, r, 4, lane);
        }
        for (int m = gw; m < M; m += NGW) rms_row_bf16(args.in[0] + (size_t)m * D, args.in[1], (bf16*)(ws + WS_XN) + (size_t)m * D, lane);
    }
    SEAM(0);
    if (IN(1)) {
        pg8::Gemm g{(const pg8::bf16_t*)(ws + WS_XN), (const pg8::bf16_t*)(ws + WS_WIN), M, NP, D}; pg8::StaticOrder S; S.init(M, NP, G, bx);
        pg8::EpiBf16 E{(pg8::bf16_t*)(ws + WS_P), NP, 0, 0};
        pg8::gemm_phase<pg8::EpiBf16, pg8::StaticOrder, true, true>(lds, g, S, E);
    }
    SEAM(1);
    if (IN(2)) {
        for (int it = bx; it < 256; it += G) compress_item(args, lds, it, tid);
        for (int it = bx; it < 2048; it += G) vtrans_item(args, lds, it, tid);
        for (int m = gw; m < M; m += NGW) conv_row(args, m, lane);
    }
    SEAM(2);
    if (IN(3)) {
        LAS int* ctl = (LAS int*)(lds + AL_CTL);
        for (;;) {
            if (tid == 0) ctl[0] = (int)atomicAdd((unsigned*)(ws + WS_CTL), 1u);
            __syncthreads();
            const int it = ctl[0];
            if (it >= 1024) break;
            attn_item(args, lds, it, tid);
        }
    }
    SEAM(3);
    if (IN(4)) {
        const bf16* OA = (const bf16*)(ws + WS_OATT); const float* ssa = (const float*)(ws + WS_SSA); bf16* MIX = (bf16*)(ws + WS_MIX); const float* gn = args.in[10];
        for (int m = gw; m < M; m += NGW) {
            const float rs = 1.0f / sqrtf((ssa[2 * m] + ssa[2 * m + 1]) * (1.f / 512.f) + EPS);
            const int ch = 8 * lane; const u32x4 v = *(const u32x4*)(OA + (size_t)m * 512 + ch);
            const f32x4 g0 = *(const f32x4*)(gn + ch), g1 = *(const f32x4*)(gn + ch + 4);
            u32x4 o; o.x = pk2(bf_lo(v.x) * rs * g0.x, bf_hi(v.x) * rs * g0.y); o.y = pk2(bf_lo(v.y) * rs * g0.z, bf_hi(v.y) * rs * g0.w);
            o.z = pk2(bf_lo(v.z) * rs * g1.x, bf_hi(v.z) * rs * g1.y); o.w = pk2(bf_lo(v.w) * rs * g1.z, bf_hi(v.w) * rs * g1.w);
            *(u32x4*)(MIX + (size_t)m * D + ch) = o;
        }
    }
    SEAM(4);
    if (IN(5)) {
        pg8::Gemm g{(const pg8::bf16_t*)(ws + WS_MIX), (const pg8::bf16_t*)(ws + WS_WOUT), M, D, D}; pg8::StaticOrder S; S.init(M, D, G, bx);
        pg8::EpiResF32 E{args.in[0], args.out, D};
        pg8::gemm_phase<pg8::EpiResF32, pg8::StaticOrder, true, true>(lds, g, S, E);
    }
    SEAM(5);
    if (IN(6)) {
        for (int m = gw; m < M; m += NGW) rms_row_bf16(args.out + (size_t)m * D, args.in[13], (bf16*)(ws + WS_XN) + (size_t)m * D, lane);
    }
    SEAM(6);
    if (IN(7)) {
        pg8::Gemm g{(const pg8::bf16_t*)(ws + WS_XN), (const pg8::bf16_t*)(ws + WS_WGU), M, NGU, D}; pg8::StaticOrder S; S.init(M, NGU, G, bx);
        pg8::EpiBf16 E{(pg8::bf16_t*)(ws + WS_GP), DFF, DFF, (size_t)(WS_UP - WS_GP) / 2};
        pg8::gemm_phase<pg8::EpiBf16, pg8::StaticOrder, true, true>(lds, g, S, E);
    }
    SEAM(7);
    if (IN(8)) {
        const bf16* GP = (const bf16*)(ws + WS_GP); bf16* UP = (bf16*)(ws + WS_UP); const float* cw = args.in[16]; const float* cb = args.in[17];
        for (int m = gw; m < M; m += NGW) {
            const int t = m & (T - 1); const bf16* gr = GP + (size_t)m * DFF;
            for (int ch = 8 * lane; ch < DFF; ch += 512) {
                const u32x4 g2 = *(const u32x4*)(gr + ch);
                const u32x4 g1 = t >= 1 ? *(const u32x4*)(gr - DFF + ch) : (u32x4){0u, 0u, 0u, 0u};
                const u32x4 g0 = t >= 2 ? *(const u32x4*)(gr - 2 * DFF + ch) : (u32x4){0u, 0u, 0u, 0u};
                const u32x4 uv = *(const u32x4*)(UP + (size_t)m * DFF + ch);
                float gt[8], uu[8];
#pragma unroll
                for (int e = 0; e < 4; ++e) {
                    const f32x2 w0 = *(const f32x2*)(cw + ch + 2 * e), w1 = *(const f32x2*)(cw + DFF + ch + 2 * e), w2 = *(const f32x2*)(cw + 2 * DFF + ch + 2 * e), bb = *(const f32x2*)(cb + ch + 2 * e);
                    gt[2 * e] = w0.x * bf_lo(g0[e]) + w1.x * bf_lo(g1[e]) + w2.x * bf_lo(g2[e]) + bb.x;
                    gt[2 * e + 1] = w0.y * bf_hi(g0[e]) + w1.y * bf_hi(g1[e]) + w2.y * bf_hi(g2[e]) + bb.y;
                    uu[2 * e] = bf_lo(uv[e]); uu[2 * e + 1] = bf_hi(uv[e]);
                }
                u32x4 o;
#pragma unroll
                for (int e = 0; e < 4; ++e) { const float a0 = gt[2 * e] * sigmoidf_(gt[2 * e]) * uu[2 * e], a1 = gt[2 * e + 1] * sigmoidf_(gt[2 * e + 1]) * uu[2 * e + 1]; o[e] = pk2(a0, a1); }
                *(u32x4*)(UP + (size_t)m * DFF + ch) = o;
            }
        }
    }
    SEAM(8);
    if (IN(9)) {
        pg8::Gemm g{(const pg8::bf16_t*)(ws + WS_UP), (const pg8::bf16_t*)(ws + WS_WDN), M, D, DFF}; pg8::StaticOrder S; S.init(M, D, G, bx);
        pg8::EpiResF32 E{args.out, args.out, D};
        pg8::gemm_phase<pg8::EpiResF32, pg8::StaticOrder, true, true>(lds, g, S, E);
    }
    SEAM(9);
    if (IN(10)) {
        const float* gn = args.in[19];
        for (int m = gw; m < M; m += NGW) {
            f32x4* xr = (f32x4*)(args.out + (size_t)m * D) + lane; const f32x4* gr = (const f32x4*)gn + lane;
            f32x4 v[4]; float s = 0.f;
#pragma unroll
            for (int j = 0; j < 4; ++j) { v[j] = xr[64 * j]; s += (v[j].x * v[j].x + v[j].y * v[j].y) + (v[j].z * v[j].z + v[j].w * v[j].w); }
            const float rs = 1.0f / sqrtf(wave_sum(s) * (1.f / D) + EPS);
#pragma unroll
            for (int j = 0; j < 4; ++j) xr[64 * j] = v[j] * rs * gr[64 * j];
        }
    }
#undef IN
#undef SEAM
}

extern "C" void kernel_launch(void* const* d_in, const int* in_sizes, int n_in, void* d_out, int out_size, void* d_ws, size_t ws_size, hipStream_t stream) {
    static int grid = 0;
    if (grid == 0) {
        if (n_in != 20 || in_sizes[0] != M * D || out_size != M * D || ws_size < WS_END) { fprintf(stderr, "kernel_launch: unexpected sizes n_in %d in0 %d out %d ws %zu\n", n_in, n_in > 0 ? in_sizes[0] : -1, out_size, ws_size); grid = -1; return; }
        int dev = 0, cus = 0, per_cu = 0;
        hipGetDevice(&dev); hipDeviceGetAttribute(&cus, hipDeviceAttributeMultiprocessorCount, dev);
        if (hipFuncSetAttribute((const void*)hymba_fwd, hipFuncAttributeMaxDynamicSharedMemorySize, LDS_BYTES) != hipSuccess) { fprintf(stderr, "kernel_launch: hipFuncSetAttribute failed\n"); grid = -1; return; }
        if (hipOccupancyMaxActiveBlocksPerMultiprocessor(&per_cu, (const void*)hymba_fwd, NWAVES * 64, LDS_BYTES) != hipSuccess || per_cu < 1) { fprintf(stderr, "kernel_launch: occupancy query says %d\n", per_cu); per_cu = 1; }
        (void)hipGetLastError();
        grid = cus * per_cu;
    }
    if (grid < 0) return;
    Args a{};
    for (int i = 0; i < 20; ++i) a.in[i] = (const float*)d_in[i];
    a.out = (float*)d_out; a.ws = (unsigned char*)d_ws;
#if MK_N_LAUNCHES == 1
    a.ph_lo = 0; a.ph_hi = NPHASE;
    void* kargs[] = {&a};
    hipError_t e = hipLaunchCooperativeKernel((const void*)hymba_fwd, dim3(grid), dim3(NWAVES * 64), kargs, LDS_BYTES, stream);
    if (e != hipSuccess) fprintf(stderr, "cooperative launch failed: %s (grid %d)\n", hipGetErrorString(e), grid);
#else
    for (int p = 0; p < NPHASE; ++p) { a.ph_lo = p; a.ph_hi = p + 1; hipLaunchKernelGGL(hymba_fwd, dim3(grid), dim3(NWAVES * 64), LDS_BYTES, stream, a); }
#endif
}
```

```cpp
#include <hip/hip_runtime.h>
#include <hip/hip_cooperative_groups.h>
#include <cstdio>
#include <cstdint>
namespace cg = cooperative_groups;
namespace pg8 {
#define PG8_LAS __attribute__((address_space(3)))
typedef unsigned short bf16_t;
typedef short bf16x8 __attribute__((ext_vector_type(8)));
typedef float f32x4 __attribute__((ext_vector_type(4)));
typedef unsigned u32x4 __attribute__((ext_vector_type(4)));
constexpr int BM = 256, BK = 64, HALF = 128, HTB = HALF * BK * 2  , STAGE_BYTES = 8 * HTB, NXCD = 8, WGM = 8;

__host__ __device__ __forceinline__ int lds_byte(int r, int c) { const int st = (r >> 4) * 2 + (c >> 5), rr = r & 15, cc = c & 31, ob = rr * 64 + cc * 2; return st * 1024 + (ob ^ (((ob >> 9) & 1) << 5)); }
__host__ __device__ __forceinline__ void stage_rc(int b, int& R, int& C) { const int st = b / 1024, sb = b % 1024, swz = sb ^ (((sb >> 9) & 1) << 5); R = (st >> 1) * 16 + swz / 64; C = (st & 1) * 32 + (swz % 64) / 2; }
__host__ __device__ __forceinline__ int perm32(int rho) { const int n = rho >> 4, i = rho & 15; return 8 * (i >> 2) + 4 * n + (i & 3); }

struct Unit { int pm, pn; };
struct Gemm { const bf16_t* A; const bf16_t* Bt; int M, N, K; };

struct StaticOrder {
    int nM, nN, nwg, G, c;
    __host__ __device__ void init(int M, int N, int G_, int c_) { nM = M / BM; nN = N / BM; nwg = nM * nN; G = G_; c = c_; }
    __host__ __device__ bool next(int i, Unit& u) const {
        const long L = (long)i * G + c; if (L >= nwg) return false;
        int wgid = (int)L; { const int q = nwg / NXCD, r = nwg % NXCD, xcd = wgid % NXCD, off = wgid / NXCD; wgid = (xcd < r ? xcd * (q + 1) : r * (q + 1) + (xcd - r) * q) + off; }
        const int nig = WGM * nN, gid = wgid / nig, fm = gid * WGM, gsz = (nM - fm) < WGM ? (nM - fm) : WGM;
        u.pm = fm + ((wgid % nig) % gsz); u.pn = (wgid % nig) / gsz; return true;
    }
    __device__ __forceinline__ void a_ready(const Unit&) const {}
    __device__ __forceinline__ void done(const Unit&) const {}
};

__device__ __forceinline__ unsigned cvt_pk_bf16(float lo, float hi) { unsigned r; asm volatile("v_cvt_pk_bf16_f32 %0, %1, %2" : "=v"(r) : "v"(lo), "v"(hi)); return r; }

struct EpiBf16 {
    static constexpr bool PERM = true, AFTER_DRAIN = false;
    bf16_t* O; int ldc; int split_cols; size_t split_stride;
    __device__ __forceinline__ void operator()(const f32x4 (&acc)[2][2][4][2], const Unit& u, int wr, int wc, int fr, int fq) const {
        const int row0 = u.pm * BM + wr * 64 + fr; int colt = u.pn * BM; bf16_t* base = O;
        if (split_cols) { const int t = colt / split_cols; base += (size_t)t * split_stride; colt -= t * split_cols; }
        const int col0 = colt + wc * 32 + 8 * fq;
#pragma unroll
        for (int ai = 0; ai < 2; ++ai)
#pragma unroll
            for (int m = 0; m < 4; ++m) { bf16_t* rowp = base + (size_t)(row0 + ai * HALF + m * 16) * ldc + col0;
#pragma unroll
                for (int bj = 0; bj < 2; ++bj) { const f32x4 v0 = acc[ai][bj][m][0], v1 = acc[ai][bj][m][1];
                    u32x4 w; w.x = cvt_pk_bf16(v0[0], v0[1]); w.y = cvt_pk_bf16(v0[2], v0[3]); w.z = cvt_pk_bf16(v1[0], v1[1]); w.w = cvt_pk_bf16(v1[2], v1[3]);
                    *(u32x4*)(rowp + bj * HALF) = w; } }
    }
};
struct EpiResF32 {
    static constexpr bool PERM = false, AFTER_DRAIN = false;
    const float* base; float* out; int ldc;
    __device__ __forceinline__ void operator()(const f32x4 (&acc)[2][2][4][2], const Unit& u, int wr, int wc, int fr, int fq) const {
        const int col0 = u.pn * BM + wc * 32 + 4 * fq;
#pragma unroll
        for (int ai = 0; ai < 2; ++ai)
#pragma unroll
            for (int m = 0; m < 4; ++m) { const size_t off = (size_t)(u.pm * BM + ai * HALF + wr * 64 + m * 16 + fr) * ldc + col0;
#pragma unroll
                for (int bj = 0; bj < 2; ++bj)
#pragma unroll
                    for (int n = 0; n < 2; ++n) { const f32x4 bs = *(const f32x4*)(base + off + bj * HALF + n * 16); *(f32x4*)(out + off + bj * HALF + n * 16) = bs + acc[ai][bj][m][n]; } }
    }
};

template <class Epi, class Sched, bool ALIGN_EPI = false, bool SP2 = false>
__device__ __forceinline__ void gemm_phase(PG8_LAS unsigned char* lds, const Gemm g, const Sched& S, const Epi& E) {
    const int tid = threadIdx.x, wid = __builtin_amdgcn_readfirstlane(tid >> 6), lane = tid & 63, wr = wid >> 2, wc = wid & 3, fr = lane & 15, fq = lane >> 4;
    const int K = g.K, nt = K / BK;
    unsigned voffA[2], voffB[2];
#pragma unroll
    for (int i = 0; i < 2; ++i) { int R, C; stage_rc(tid * 16 + i * 8192, R, C); const int Rb = Epi::PERM ? ((R & ~31) + perm32(R & 31)) : R;
        voffA[i] = (unsigned)(R * K + C) * 2u; voffB[i] = (unsigned)(Rb * K + C) * 2u; }
    const size_t kstep = (size_t)(BK * 2);
    const size_t hstep = (size_t)HALF * K * 2;
    const size_t tstep = 2 * hstep;
    const unsigned ldsw = (unsigned)wid * 1024u;
    const int aoff = lds_byte(wr * 64 + fr, fq * 8), boff = lds_byte(wc * 32 + fr, fq * 8);
#define PG8_SA(b, h) (((b) * 2 + (h)) * HTB)
#define PG8_SB(b, h) ((4 + (b) * 2 + (h)) * HTB)
#define PG8_STAGE(bufoff, gbase, voff) do { _Pragma("unroll") for (int _i = 0; _i < 2; ++_i) \
        __builtin_amdgcn_global_load_lds((const unsigned*)((const char*)(gbase) + (voff)[_i]), (PG8_LAS unsigned*)(lds + (bufoff) + ldsw + _i * 8192), 16, 0, 0); } while (0)
#define PG8_LDA(dst, b, h) do { _Pragma("unroll") for (int m = 0; m < 4; ++m) _Pragma("unroll") for (int k = 0; k < 2; ++k) dst[m][k] = *(const PG8_LAS bf16x8*)(lds + PG8_SA(b, h) + aoff + m * 2048 + k * 1024); } while (0)
#define PG8_LDB(dst, b, h) do { _Pragma("unroll") for (int n = 0; n < 2; ++n) _Pragma("unroll") for (int k = 0; k < 2; ++k) dst[n][k] = *(const PG8_LAS bf16x8*)(lds + PG8_SB(b, h) + boff + n * 2048 + k * 1024); } while (0)
#define PG8_MMA(ai, bj, At, Bt) do { __builtin_amdgcn_s_setprio(1); _Pragma("unroll") for (int m = 0; m < 4; ++m) _Pragma("unroll") for (int n = 0; n < 2; ++n) _Pragma("unroll") for (int k = 0; k < 2; ++k) \
        acc[ai][bj][m][n] = __builtin_amdgcn_mfma_f32_16x16x32_bf16(Bt[n][k], At[m][k], acc[ai][bj][m][n], 0, 0, 0); __builtin_amdgcn_s_setprio(0); } while (0)
#define PG8_WAIT_V(n) asm volatile("s_waitcnt vmcnt(" #n ")" ::: "memory")
#define PG8_WAIT_L(n) asm volatile("s_waitcnt lgkmcnt(" #n ")" ::: "memory")
#define PG8_BAR __builtin_amdgcn_s_barrier()
#define PG8_SCHED __builtin_amdgcn_sched_barrier(0)
    Unit cur, nxt; int ui = 0;
    if (!S.next(0, cur)) return;
    f32x4 acc[2][2][4][2];
#pragma unroll
    for (int a = 0; a < 2; ++a)
#pragma unroll
        for (int b = 0; b < 2; ++b)
#pragma unroll
            for (int m = 0; m < 4; ++m)
#pragma unroll
                for (int n = 0; n < 2; ++n) acc[a][b][m][n] = (f32x4){0.f, 0.f, 0.f, 0.f};
    bf16x8 At[4][2], B0[2][2], B1[2][2];
    const char* cA = (const char*)g.A + (size_t)cur.pm * tstep; const char* cB = (const char*)g.Bt + (size_t)cur.pn * tstep;
    S.a_ready(cur);
    if constexpr (SP2) {
        PG8_STAGE(PG8_SB(0, 0), cB, voffB); PG8_STAGE(PG8_SB(0, 1), cB + hstep, voffB); PG8_STAGE(PG8_SA(0, 0), cA, voffA); PG8_STAGE(PG8_SA(0, 1), cA + hstep, voffA);
        if (wr == 1) PG8_BAR;
        PG8_WAIT_V(2); PG8_BAR;
        PG8_STAGE(PG8_SB(1, 0), cB + kstep, voffB); PG8_STAGE(PG8_SA(1, 0), cA + kstep, voffA); PG8_STAGE(PG8_SB(1, 1), cB + hstep + kstep, voffB);
        PG8_WAIT_V(6); PG8_BAR;
    } else {
        PG8_STAGE(PG8_SB(0, 0), cB, voffB); PG8_STAGE(PG8_SA(0, 0), cA, voffA); PG8_STAGE(PG8_SB(0, 1), cB + hstep, voffB); PG8_STAGE(PG8_SA(0, 1), cA + hstep, voffA);
        if (wr == 1) PG8_BAR;
        PG8_WAIT_V(4); PG8_BAR;
        PG8_STAGE(PG8_SB(1, 0), cB + kstep, voffB); PG8_STAGE(PG8_SA(1, 0), cA + kstep, voffA); PG8_STAGE(PG8_SB(1, 1), cB + hstep + kstep, voffB);
        PG8_WAIT_V(6); PG8_BAR;
    }
    for (;;) {
        const bool has_next = S.next(ui + 1, nxt);
        const char* nA = has_next ? (const char*)g.A + (size_t)nxt.pm * tstep : cA; const char* nB = has_next ? (const char*)g.Bt + (size_t)nxt.pn * tstep : cB;
        for (int t = 0; t < nt; t += 2) {
            const bool last = (t == nt - 2);
            const char* a1 = cA + (size_t)(t + 1) * kstep;
            const char* a2 = last ? nA : cA + (size_t)(t + 2) * kstep; const char* b2 = last ? nB : cB + (size_t)(t + 2) * kstep;
            const char* a3 = a2 + kstep; const char* b3 = b2 + kstep;
            if (last && has_next) S.a_ready(nxt);
            if constexpr (SP2) {
            PG8_LDB(B0, 0, 0); PG8_LDB(B1, 0, 1); PG8_SCHED; PG8_LDA(At, 0, 0); PG8_STAGE(PG8_SA(1, 1), a1 + hstep, voffA);
            PG8_WAIT_V(8); PG8_WAIT_L(0); PG8_BAR; PG8_MMA(0, 0, At, B0); PG8_MMA(0, 1, At, B1); PG8_BAR; PG8_SCHED;
            PG8_LDA(At, 0, 1); PG8_STAGE(PG8_SB(0, 0), b2, voffB); PG8_STAGE(PG8_SB(0, 1), b2 + hstep, voffB); PG8_STAGE(PG8_SA(0, 0), a2, voffA);
            PG8_WAIT_V(8); PG8_WAIT_L(0); PG8_BAR; PG8_MMA(1, 0, At, B0); PG8_MMA(1, 1, At, B1); PG8_BAR; PG8_SCHED;
            PG8_LDB(B0, 1, 0); PG8_LDB(B1, 1, 1); PG8_SCHED; PG8_LDA(At, 1, 0); PG8_STAGE(PG8_SA(0, 1), a2 + hstep, voffA);
            PG8_WAIT_V(8); PG8_WAIT_L(0); PG8_BAR; PG8_MMA(0, 0, At, B0); PG8_MMA(0, 1, At, B1); PG8_BAR; PG8_SCHED;
            PG8_LDA(At, 1, 1); PG8_STAGE(PG8_SB(1, 0), b3, voffB); PG8_STAGE(PG8_SB(1, 1), b3 + hstep, voffB); PG8_STAGE(PG8_SA(1, 0), a3, voffA);
            PG8_WAIT_V(8); PG8_WAIT_L(0); PG8_BAR; PG8_MMA(1, 0, At, B0); PG8_MMA(1, 1, At, B1); PG8_BAR; PG8_SCHED;
            } else {
            PG8_LDB(B0, 0, 0); PG8_SCHED; PG8_LDA(At, 0, 0); PG8_STAGE(PG8_SA(1, 1), a1 + hstep, voffA);
            PG8_WAIT_L(8); PG8_BAR; PG8_WAIT_L(0); PG8_MMA(0, 0, At, B0); PG8_BAR; PG8_SCHED;
            PG8_LDB(B1, 0, 1); PG8_STAGE(PG8_SB(0, 0), b2, voffB);
            PG8_BAR; PG8_WAIT_L(0); PG8_MMA(0, 1, At, B1); PG8_BAR;
            PG8_LDA(At, 0, 1); PG8_STAGE(PG8_SA(0, 0), a2, voffA);
            PG8_BAR; PG8_WAIT_L(0); PG8_MMA(1, 0, At, B0); PG8_BAR; PG8_SCHED;
            PG8_STAGE(PG8_SB(0, 1), b2 + hstep, voffB);
            PG8_WAIT_V(6); PG8_BAR; PG8_MMA(1, 1, At, B1); PG8_BAR;
            PG8_LDB(B0, 1, 0); PG8_SCHED; PG8_LDA(At, 1, 0); PG8_STAGE(PG8_SA(0, 1), a2 + hstep, voffA);
            PG8_WAIT_L(8); PG8_BAR; PG8_WAIT_L(0); PG8_MMA(0, 0, At, B0); PG8_BAR; PG8_SCHED;
            PG8_LDB(B1, 1, 1); PG8_STAGE(PG8_SB(1, 0), b3, voffB);
            PG8_BAR; PG8_WAIT_L(0); PG8_MMA(0, 1, At, B1); PG8_BAR;
            PG8_LDA(At, 1, 1); PG8_STAGE(PG8_SA(1, 0), a3, voffA);
            PG8_BAR; PG8_WAIT_L(0); PG8_MMA(1, 0, At, B0); PG8_BAR; PG8_SCHED;
            PG8_STAGE(PG8_SB(1, 1), b3 + hstep, voffB);
            PG8_WAIT_V(6); PG8_BAR; PG8_MMA(1, 1, At, B1); PG8_BAR;
            }
        }
        if constexpr (ALIGN_EPI) { if (wr == 0) PG8_BAR; }
        if constexpr (!Epi::AFTER_DRAIN) { E(acc, cur, wr, wc, fr, fq); S.done(cur); }
        if (!has_next) break;
#pragma unroll
        for (int a = 0; a < 2; ++a)
#pragma unroll
            for (int b = 0; b < 2; ++b)
#pragma unroll
                for (int m = 0; m < 4; ++m)
#pragma unroll
                    for (int n = 0; n < 2; ++n) acc[a][b][m][n] = (f32x4){0.f, 0.f, 0.f, 0.f};
        cur = nxt; cA = nA; cB = nB; ++ui;
        if constexpr (ALIGN_EPI) { if (wr == 1) PG8_BAR; }
    }
    PG8_WAIT_V(0);
    if constexpr (!ALIGN_EPI) { if (wr == 0) PG8_BAR; }
    PG8_BAR;
    if constexpr (Epi::AFTER_DRAIN) { E.fused(acc, cur, wr, wc, fr, fq, lds, wid, lane); S.done(cur); }
#undef PG8_SA
#undef PG8_SB
#undef PG8_STAGE
#undef PG8_LDA
#undef PG8_LDB
#undef PG8_MMA
#undef PG8_WAIT_V
#undef PG8_WAIT_L
#undef PG8_BAR
#undef PG8_SCHED
}
}

#ifndef MK_N_LAUNCHES
#define MK_N_LAUNCHES 1
#endif
constexpr int NWAVES = 8;
constexpr int BATCH = 8, T = 4096, D = 1024, M = BATCH * T;
constexpr int NPROJ = 2840, NP = 3072;
constexpr int DFF = 2816, NGU = 2 * DFF;
constexpr int COL_Q = 0, COL_KC = 512, COL_VC = 640, COL_KS = 768, COL_VS = 896, COL_KW = 1024, COL_VW = 1152, COL_G = 1280, COL_BG = 1304, COL_CG = 1816, COL_U = 2328;
constexpr float EPS = 1e-6f;
constexpr float LOG2E = 1.4426950408889634f;

constexpr size_t MiB = 1u << 20;
constexpr size_t WS_CTL = 0;
constexpr size_t WS_WIN = 2 * MiB, WS_WOUT = 8 * MiB, WS_WGU = 10 * MiB, WS_WDN = 21 * MiB;
constexpr size_t WS_WC1K = 27 * MiB, WS_WC1V = 27 * MiB + 512 * 1024;
constexpr size_t WS_KCMP = 28 * MiB, WS_VCMPT = 28 * MiB + 512 * 1024, WS_SSA = 29 * MiB;
constexpr size_t WS_XN = 32 * MiB, WS_MIX = 96 * MiB, WS_P = 160 * MiB;
constexpr size_t WS_VTS = 352 * MiB, WS_VTW = 360 * MiB, WS_OATT = 368 * MiB;
constexpr size_t WS_GP = 160 * MiB, WS_UP = 336 * MiB, WS_END = 512 * MiB;
static_assert(WS_P + (size_t)M * NP * 2 <= WS_VTS && WS_GP + (size_t)M * DFF * 2 <= WS_UP && WS_UP + (size_t)M * DFF * 2 <= WS_END, "ws map");

constexpr int CW_BAR = 4096;
constexpr size_t CTL_ZERO_BYTES = 65536;
constexpr int RING_BYTES = 131072;
constexpr int BARLDS_OFF = RING_BYTES + 512;
constexpr int LDS_BYTES = 147456;

#define LAS __attribute__((address_space(3)))
typedef unsigned short bf16;
typedef unsigned u32x4 __attribute__((ext_vector_type(4)));
typedef unsigned u32x2 __attribute__((ext_vector_type(2)));
typedef float f32x4 __attribute__((ext_vector_type(4)));
typedef float f32x2 __attribute__((ext_vector_type(2)));
typedef short bf16x8 __attribute__((ext_vector_type(8)));
typedef short s16x4 __attribute__((ext_vector_type(4)));
typedef __bf16 bf16x2_t __attribute__((ext_vector_type(2)));

__device__ __forceinline__ unsigned pk2(float lo, float hi) { f32x2 v = {lo, hi}; bf16x2_t b = __builtin_convertvector(v, bf16x2_t); return __builtin_bit_cast(unsigned, b); }
__device__ __forceinline__ float bf_lo(unsigned u) { return __uint_as_float(u << 16); }
__device__ __forceinline__ float bf_hi(unsigned u) { return __uint_as_float(u & 0xffff0000u); }
__device__ __forceinline__ float bf1(bf16 u) { return __uint_as_float((unsigned)u << 16); }
__device__ __forceinline__ float wave_sum(float v) {
#pragma unroll
    for (int o = 1; o < 64; o <<= 1) v += __shfl_xor(v, o);
    return v;
}
__device__ __forceinline__ float sigmoidf_(float x) { return 1.0f / (1.0f + __expf(-x)); }

struct Args { const float* in[20]; float* out; unsigned char* ws; int ph_lo, ph_hi; };

__device__ __forceinline__ void p0_transpose_item(const float* W, int K, int Nsrc, bf16* WT, int row_off, LAS float* scr, int item, int nblk, int lane) {
    const int kb = item / nblk, nb = item % nblk, k0 = 64 * kb, n0 = 32 * nb;
    const int n = n0 + (lane & 31);
#pragma unroll 8
    for (int i = 0; i < 32; ++i) { const int kk = 2 * i + (lane >> 5); scr[kk * 33 + (lane & 31)] = (n < Nsrc) ? W[(size_t)(k0 + kk) * Nsrc + n] : 0.f; }
    asm volatile("s_waitcnt lgkmcnt(0)" ::: "memory");
    const int c = lane & 7;
#pragma unroll
    for (int j = 0; j < 4; ++j) { const int nn = (lane >> 3) + 8 * j; const LAS float* s = scr + (8 * c) * 33 + nn;
        u32x4 o; o.x = pk2(s[0 * 33], s[1 * 33]); o.y = pk2(s[2 * 33], s[3 * 33]); o.z = pk2(s[4 * 33], s[5 * 33]); o.w = pk2(s[6 * 33], s[7 * 33]);
        *(u32x4*)(WT + (size_t)(row_off + n0 + nn) * K + k0 + 8 * c) = o; }
    asm volatile("s_waitcnt lgkmcnt(0)" ::: "memory");
}
__device__ __forceinline__ void rms_row_bf16(const float* xrow, const float* g, bf16* orow, int lane) {
    const f32x4* xr = (const f32x4*)xrow + lane; const f32x4* gr = (const f32x4*)g + lane;
    f32x4 v[4]; float s = 0.f;
#pragma unroll
    for (int j = 0; j < 4; ++j) { v[j] = xr[64 * j]; s += (v[j].x * v[j].x + v[j].y * v[j].y) + (v[j].z * v[j].z + v[j].w * v[j].w); }
    const float rs = 1.0f / sqrtf(wave_sum(s) * (1.f / D) + EPS);
    u32x2* o8 = (u32x2*)orow + lane;
#pragma unroll
    for (int j = 0; j < 4; ++j) { const f32x4 gg = gr[64 * j]; u32x2 o; o.x = pk2(v[j].x * rs * gg.x, v[j].y * rs * gg.y); o.y = pk2(v[j].z * rs * gg.z, v[j].w * rs * gg.w); o8[64 * j] = o; }
}

__device__ __forceinline__ float gelu_tanh(float x) { const float u = 0.7978845608028654f * (x + 0.044715f * x * x * x); return 0.5f * x * (1.0f + tanhf(u)); }

__device__ __forceinline__ void compress_item(const Args& a, LAS unsigned char* lds, int item, int tid) {
    const int lane = tid & 63, w = __builtin_amdgcn_readfirstlane(tid >> 6), r16 = lane & 15, kq = lane >> 4;
    const int kv = item >> 7, b = (item >> 4) & 7, h = (item >> 3) & 1, ib = item & 7;
    unsigned char* ws = a.ws;
    const bf16* P = (const bf16*)(ws + WS_P);
    const bf16* W1T = (const bf16*)(ws + (kv ? WS_WC1V : WS_WC1K));
    const float* pos = a.in[kv ? 6 : 3];
    const float* w1 = a.in[kv ? 7 : 4];
    const float* w2 = a.in[kv ? 8 : 5];
    LAS unsigned char* Al = lds;
    LAS float* hid = (LAS float*)(lds + 67584);
    LAS float* bpart = (LAS float*)(lds + 67584 + 16512);
    const int col0 = (kv ? COL_VC : COL_KC) + h * 64;
    for (int idx = tid; idx < 528 * 8; idx += 512) {
        const int tau = idx >> 3, c = idx & 7; int tok = 512 * ib + tau; tok = tok < T ? tok : T - 1;
        const u32x4 v = *(const u32x4*)(P + (size_t)(b * T + tok) * NP + col0 + 8 * c);
        *(LAS u32x4*)(Al + tau * 128 + ((c ^ ((tau >> 4) & 7)) << 4)) = v;
    }
    {
        const int n = tid & 127, part = tid >> 7; float s = 0.f;
#pragma unroll 8
        for (int k = 0; k < 512; ++k) { const int kk = part * 512 + k; s += pos[kk] * w1[(size_t)kk * 128 + n]; }
        bpart[part * 128 + n] = s;
    }
    __syncthreads();
    f32x4 acc0 = {0.f, 0.f, 0.f, 0.f}, acc1 = {0.f, 0.f, 0.f, 0.f};
    const bf16* wrow = W1T + (size_t)(16 * w + r16) * 2048 + 8 * kq;
#pragma unroll 8
    for (int s = 0; s < 64; ++s) {
        const bf16x8 af = *(const bf16x8*)(wrow + 32 * s);
        const int l = s >> 1, c = (s & 1) * 4 + kq;
        const int tau0 = 16 * r16 + l, tau1 = tau0 + 256;
        const bf16x8 b0 = *(const LAS bf16x8*)(Al + tau0 * 128 + ((c ^ ((tau0 >> 4) & 7)) << 4));
        const bf16x8 b1 = *(const LAS bf16x8*)(Al + tau1 * 128 + ((c ^ ((tau1 >> 4) & 7)) << 4));
        acc0 = __builtin_amdgcn_mfma_f32_16x16x32_bf16(af, b0, acc0, 0, 0, 0);
        acc1 = __builtin_amdgcn_mfma_f32_16x16x32_bf16(af, b1, acc1, 0, 0, 0);
    }
#pragma unroll
    for (int j = 0; j < 4; ++j) { const int n = 16 * w + 4 * kq + j; const float bs = (bpart[n] + bpart[128 + n]) + (bpart[256 + n] + bpart[384 + n]);
        hid[r16 * 129 + n] = gelu_tanh(acc0[j] + bs); hid[(16 + r16) * 129 + n] = gelu_tanh(acc1[j] + bs); }
    __syncthreads();
    {
        const int i = tid >> 4, d4 = (tid & 15) * 4; f32x4 o = {0.f, 0.f, 0.f, 0.f};
#pragma unroll 8
        for (int n = 0; n < 128; ++n) { const float hv = hid[i * 129 + n]; const f32x4 wv = *(const f32x4*)(w2 + n * 64 + d4); o += hv * wv; }
        const int ig = 32 * ib + i;
        if (ig == 255) o = (f32x4){0.f, 0.f, 0.f, 0.f};
        if (kv == 0) { bf16* K = (bf16*)(ws + WS_KCMP); u32x2 pk; pk.x = pk2(o.x, o.y); pk.y = pk2(o.z, o.w); *(u32x2*)(K + ((size_t)(b * 2 + h) * 256 + ig) * 64 + d4) = pk; }
        else { bf16* Vt = (bf16*)(ws + WS_VCMPT);
#pragma unroll
            for (int e = 0; e < 4; ++e) Vt[((size_t)(b * 2 + h) * 64 + d4 + e) * 256 + ig] = (bf16)(pk2(o[e], 0.f) & 0xffffu); }
    }
    __syncthreads();
}

__device__ __forceinline__ void vtrans_item(const Args& a, LAS unsigned char* lds, int item, int tid) {
    const int which = item >> 10, b = (item >> 7) & 7, hk = (item >> 6) & 1, tt = item & 63;
    const bf16* P = (const bf16*)(a.ws + WS_P);
    bf16* VT = (bf16*)(a.ws + (which ? WS_VTW : WS_VTS));
    const int r = tid >> 3, c = tid & 7;
    const u32x4 v = *(const u32x4*)(P + (size_t)(b * T + 64 * tt + r) * NP + (which ? COL_VW : COL_VS) + hk * 64 + 8 * c);
    *(LAS u32x4*)(lds + r * 144 + c * 16) = v;
    __syncthreads();
    const int d = tid >> 3;
    unsigned short e[8];
#pragma unroll
    for (int j = 0; j < 8; ++j) e[j] = *(const LAS unsigned short*)(lds + (8 * c + j) * 144 + d * 2);
    u32x4 o; o.x = e[0] | ((unsigned)e[1] << 16); o.y = e[2] | ((unsigned)e[3] << 16); o.z = e[4] | ((unsigned)e[5] << 16); o.w = e[6] | ((unsigned)e[7] << 16);
    *(u32x4*)(VT + ((size_t)(b * 2 + hk) * 64 + d) * T + 64 * tt + 8 * c) = o;
    __syncthreads();
}

__device__ __forceinline__ void conv_row(const Args& a, int m, int lane) {
    const bf16* P = (const bf16*)(a.ws + WS_P); bf16* MIX = (bf16*)(a.ws + WS_MIX);
    const float* cw = a.in[9]; const float* gn = a.in[11];
    const int t = m & (T - 1), ch = 8 * lane;
    const bf16* row = P + (size_t)m * NP;
    float y[8];
#pragma unroll
    for (int e = 0; e < 8; ++e) y[e] = 0.f;
#pragma unroll
    for (int k = 0; k < 3; ++k) {
        const int dt = 2 - k;
        if (t - dt >= 0) {
            const u32x4 cv = *(const u32x4*)(row - (size_t)dt * NP + COL_CG + ch), uv = *(const u32x4*)(row - (size_t)dt * NP + COL_U + ch);
            const f32x4 w0 = *(const f32x4*)(cw + k * 512 + ch), w1 = *(const f32x4*)(cw + k * 512 + ch + 4);
            y[0] += w0.x * bf_lo(cv.x) * bf_lo(uv.x); y[1] += w0.y * bf_hi(cv.x) * bf_hi(uv.x);
            y[2] += w0.z * bf_lo(cv.y) * bf_lo(uv.y); y[3] += w0.w * bf_hi(cv.y) * bf_hi(uv.y);
            y[4] += w1.x * bf_lo(cv.z) * bf_lo(uv.z); y[5] += w1.y * bf_hi(cv.z) * bf_hi(uv.z);
            y[6] += w1.z * bf_lo(cv.w) * bf_lo(uv.w); y[7] += w1.w * bf_hi(cv.w) * bf_hi(uv.w);
        }
    }
    const u32x4 bv = *(const u32x4*)(row + COL_BG + ch);
    y[0] *= bf_lo(bv.x); y[1] *= bf_hi(bv.x); y[2] *= bf_lo(bv.y); y[3] *= bf_hi(bv.y); y[4] *= bf_lo(bv.z); y[5] *= bf_hi(bv.z); y[6] *= bf_lo(bv.w); y[7] *= bf_hi(bv.w);
    float s = 0.f;
#pragma unroll
    for (int e = 0; e < 8; ++e) s += y[e] * y[e];
    const float rs = 1.0f / sqrtf(wave_sum(s) * (1.f / 512.f) + EPS);
    const f32x4 g0 = *(const f32x4*)(gn + ch), g1 = *(const f32x4*)(gn + ch + 4);
    u32x4 o; o.x = pk2(y[0] * rs * g0.x, y[1] * rs * g0.y); o.y = pk2(y[2] * rs * g0.z, y[3] * rs * g0.w); o.z = pk2(y[4] * rs * g1.x, y[5] * rs * g1.y); o.w = pk2(y[6] * rs * g1.z, y[7] * rs * g1.w);
    *(u32x4*)(MIX + (size_t)m * D + 512 + ch) = o;
}

constexpr int AL_K0 = 0, AL_V0 = 18432, AL_IMP = 36864, AL_SELM = 54272, AL_WUN = 54784, AL_CTL = 54848;
constexpr int TPITCH = 144;
constexpr int IMPP = 68;

struct TileRegs { u32x4 k, v; };
__device__ __forceinline__ TileRegs tile_load(const bf16* kb, size_t kp, const bf16* vb, size_t vp, int tid) {
    const int r = tid >> 3, c = tid & 7; TileRegs t;
    t.k = *(const u32x4*)(kb + (size_t)r * kp + 8 * c); t.v = *(const u32x4*)(vb + (size_t)r * vp + 8 * c); return t;
}
__device__ __forceinline__ void tile_store(LAS unsigned char* lds, int buf, const TileRegs& t, int tid) {
    const int r = tid >> 3, c = tid & 7;
    *(LAS u32x4*)(lds + AL_K0 + buf * 9216 + r * TPITCH + c * 16) = t.k;
    *(LAS u32x4*)(lds + AL_V0 + buf * 9216 + r * TPITCH + c * 16) = t.v;
}

template <int MODE>
__device__ __forceinline__ void tile_compute(LAS unsigned char* lds, int buf, int pos0, int t, const bf16x8 (&Qf)[2][2], const float (&sl2)[2],
                                             float (&mrow)[2], float (&lrow)[2], f32x4 (&O)[2][4], bool selbit, LAS float* improw, int impj0, int lane) {
    const int r16 = lane & 15, kq = lane >> 4;
    const LAS unsigned char* Kb = lds + AL_K0 + buf * 9216; const LAS unsigned char* Vb = lds + AL_V0 + buf * 9216;
    f32x4 st[2][4];
#pragma unroll
    for (int qb = 0; qb < 2; ++qb)
#pragma unroll
        for (int kb = 0; kb < 4; ++kb) st[qb][kb] = (f32x4){0.f, 0.f, 0.f, 0.f};
#pragma unroll
    for (int kb = 0; kb < 4; ++kb)
#pragma unroll
        for (int ks = 0; ks < 2; ++ks) { const bf16x8 kf = *(const LAS bf16x8*)(Kb + (16 * kb + r16) * TPITCH + (32 * ks + 8 * kq) * 2);
#pragma unroll
            for (int qb = 0; qb < 2; ++qb) st[qb][kb] = __builtin_amdgcn_mfma_f32_16x16x32_bf16(kf, Qf[qb][ks], st[qb][kb], 0, 0, 0); }
    const float sc = 0.125f * LOG2E;
    float tmax[2] = {-1e30f, -1e30f};
    bool valid[4][4];
#pragma unroll
    for (int kb = 0; kb < 4; ++kb)
#pragma unroll
        for (int j = 0; j < 4; ++j) {
            const int kidx = 16 * kb + 4 * kq + j; int dist;
            if (MODE <= 1) dist = t - (16 * (pos0 + kidx) + 31); else dist = t - (pos0 + kidx);
            bool v = dist >= 0;
            if (MODE == 2) v = v && selbit;
            if (MODE == 3) v = v && (dist < 512);
            valid[kb][j] = v; const float fd = (float)dist;
#pragma unroll
            for (int qb = 0; qb < 2; ++qb) { float s = st[qb][kb][j] * sc - sl2[qb] * fd; s = v ? s : -1e30f; st[qb][kb][j] = s; tmax[qb] = fmaxf(tmax[qb], s); }
        }
    float mnew[2], alpha[2];
#pragma unroll
    for (int qb = 0; qb < 2; ++qb) {
        if (MODE == 1) { mnew[qb] = mrow[qb]; alpha[qb] = 1.f; }
        else { float tm = tmax[qb]; tm = fmaxf(tm, __shfl_xor(tm, 16)); tm = fmaxf(tm, __shfl_xor(tm, 32)); mnew[qb] = fmaxf(mrow[qb], tm); alpha[qb] = __builtin_amdgcn_exp2f(mrow[qb] - mnew[qb]); mrow[qb] = mnew[qb]; }
    }
#pragma unroll
    for (int qb = 0; qb < 2; ++qb) {
        float ps = 0.f;
#pragma unroll
        for (int kb = 0; kb < 4; ++kb)
#pragma unroll
            for (int j = 0; j < 4; ++j) { float p = valid[kb][j] ? __builtin_amdgcn_exp2f(st[qb][kb][j] - mnew[qb]) : 0.f; if (MODE == 1) p *= lrow[qb]; st[qb][kb][j] = p; ps += p; }
        if (MODE != 1) lrow[qb] = lrow[qb] * alpha[qb] + ps;
    }
    if (MODE == 0) return;
    if (MODE == 1) {
#pragma unroll
        for (int kb = 0; kb < 4; ++kb) {
            float vm = (st[0][kb][0] + st[0][kb][1]) + (st[0][kb][2] + 0.5f * st[0][kb][3]) + (st[1][kb][0] + st[1][kb][1]) + (st[1][kb][2] + 0.5f * st[1][kb][3]);
            float vh = 0.5f * st[0][kb][3] + 0.5f * st[1][kb][3];
            vm += __shfl_xor(vm, 8); vh += __shfl_xor(vh, 8);
            const int jj = impj0 + 4 * kb + kq;
            if ((lane & 8) == 0) { improw[jj] += vm; }
            if ((lane & 8) == 0) { improw[jj + 1] += vh; }
        }
    }
    if (MODE >= 2) {
#pragma unroll
        for (int qb = 0; qb < 2; ++qb)
#pragma unroll
            for (int db = 0; db < 4; ++db) O[qb][db] *= alpha[qb];
    }
    bf16x8 Pf[2][2];
#pragma unroll
    for (int qb = 0; qb < 2; ++qb)
#pragma unroll
        for (int s2 = 0; s2 < 2; ++s2) { u32x4 w; w.x = pk2(st[qb][2 * s2][0], st[qb][2 * s2][1]); w.y = pk2(st[qb][2 * s2][2], st[qb][2 * s2][3]);
            w.z = pk2(st[qb][2 * s2 + 1][0], st[qb][2 * s2 + 1][1]); w.w = pk2(st[qb][2 * s2 + 1][2], st[qb][2 * s2 + 1][3]); Pf[qb][s2] = __builtin_bit_cast(bf16x8, w); }
#pragma unroll
    for (int db = 0; db < 4; ++db)
#pragma unroll
        for (int s2 = 0; s2 < 2; ++s2) {
            const u32x2 lo = *(const LAS u32x2*)(Vb + (16 * db + r16) * TPITCH + (32 * s2 + 4 * kq) * 2);
            const u32x2 hi = *(const LAS u32x2*)(Vb + (16 * db + r16) * TPITCH + (32 * s2 + 16 + 4 * kq) * 2);
            u32x4 w; w.x = lo.x; w.y = lo.y; w.z = hi.x; w.w = hi.y; const bf16x8 vf = __builtin_bit_cast(bf16x8, w);
#pragma unroll
            for (int qb = 0; qb < 2; ++qb) O[qb][db] = __builtin_amdgcn_mfma_f32_16x16x32_bf16(vf, Pf[qb][s2], O[qb][db], 0, 0, 0);
        }
}

__device__ __forceinline__ void attn_item(const Args& a, LAS unsigned char* lds, int it, int tid) {
    const int lane = tid & 63, w = __builtin_amdgcn_readfirstlane(tid >> 6), r16 = lane & 15, kq = lane >> 4, tql = r16 & 7, gl = r16 >> 3;
    const int c = 63 - (it >> 4), b = (it >> 1) & 7, hk = it & 1;
    unsigned char* ws = a.ws;
    const bf16* P = (const bf16*)(ws + WS_P);
    const bf16* KC = (const bf16*)(ws + WS_KCMP) + (size_t)(b * 2 + hk) * 256 * 64;
    const bf16* VCT = (const bf16*)(ws + WS_VCMPT) + (size_t)(b * 2 + hk) * 64 * 256;
    const bf16* VTS = (const bf16*)(ws + WS_VTS) + (size_t)(b * 2 + hk) * 64 * T;
    const bf16* VTW = (const bf16*)(ws + WS_VTW) + (size_t)(b * 2 + hk) * 64 * T;
    const bf16* PKS = P + (size_t)b * T * NP + COL_KS + hk * 64;
    const bf16* PKW = P + (size_t)b * T * NP + COL_KW + hk * 64;
    const int tq = 8 * w + tql, t = 64 * c + tq; const size_t R = (size_t)b * T + t;
    LAS float* imp = (LAS float*)(lds + AL_IMP); LAS unsigned* selm = (LAS unsigned*)(lds + AL_SELM); LAS unsigned* wunl = (LAS unsigned*)(lds + AL_WUN);
    LAS float* improw = imp + tq * IMPP;

    bf16x8 Qf[2][2]; float sl2[2];
#pragma unroll
    for (int qb = 0; qb < 2; ++qb) { const int hq = hk * 4 + 2 * qb + gl; sl2[qb] = LOG2E * exp2f(-(float)(hq + 1));
#pragma unroll
        for (int ks = 0; ks < 2; ++ks) Qf[qb][ks] = *(const bf16x8*)(P + R * NP + COL_Q + hq * 64 + 32 * ks + 8 * kq); }
    float gate[2][3];
#pragma unroll
    for (int qb = 0; qb < 2; ++qb)
#pragma unroll
        for (int br = 0; br < 3; ++br) gate[qb][br] = sigmoidf_(bf1(P[R * NP + COL_G + hk * 12 + (2 * qb + gl) * 3 + br]));
    for (int i = lane; i < 8 * IMPP; i += 64) imp[(8 * w) * IMPP + i] = 0.f;

    f32x4 out[2][4], O[2][4];
#pragma unroll
    for (int qb = 0; qb < 2; ++qb)
#pragma unroll
        for (int db = 0; db < 4; ++db) { out[qb][db] = (f32x4){0.f, 0.f, 0.f, 0.f}; O[qb][db] = (f32x4){0.f, 0.f, 0.f, 0.f}; }
    float mrow[2] = {-1e30f, -1e30f}, lrow[2] = {0.f, 0.f};
    int buf = 0;
    TileRegs tr;

    const int nct = (4 * c + 3 + 63) >> 6;
    tr = tile_load(KC, 64, VCT, 256, tid);
    for (int ti = 0; ti < nct; ++ti) {
        tile_store(lds, buf, tr, tid); __syncthreads();
        { const int nx = (ti + 1 < nct) ? ti + 1 : 0; tr = tile_load(KC + (size_t)nx * 64 * 64, 64, VCT + nx * 64, 256, tid); }
        tile_compute<0>(lds, buf, 64 * ti, t, Qf, sl2, mrow, lrow, O, true, improw, 0, lane);
        buf ^= 1;
    }
#pragma unroll
    for (int qb = 0; qb < 2; ++qb) { float l = lrow[qb]; l += __shfl_xor(l, 16); l += __shfl_xor(l, 32); lrow[qb] = l > 0.f ? 1.0f / l : 0.f; }
    for (int ti = 0; ti < nct; ++ti) {
        tile_store(lds, buf, tr, tid); __syncthreads();
        if (ti + 1 < nct) tr = tile_load(KC + (size_t)(ti + 1) * 64 * 64, 64, VCT + (ti + 1) * 64, 256, tid);
        tile_compute<1>(lds, buf, 64 * ti, t, Qf, sl2, mrow, lrow, O, true, improw, 16 * ti, lane);
        buf ^= 1;
    }
#pragma unroll
    for (int qb = 0; qb < 2; ++qb)
#pragma unroll
        for (int db = 0; db < 4; ++db) { out[qb][db] = gate[qb][0] * O[qb][db]; O[qb][db] = (f32x4){0.f, 0.f, 0.f, 0.f}; }

    unsigned long long wun = 0ull;
    for (int tt = 0; tt < 8; ++tt) {
        LAS float* row = imp + (8 * w + tt) * IMPP;
        float mine = row[lane];
        if (lane == 0 || lane == c || lane == c - 1) mine = 1e30f;
        if (lane > c) mine = -1e30f;
        row[lane] = mine;
        int rank = 0;
#pragma unroll
        for (int i4 = 0; i4 < 16; ++i4) { const f32x4 v = *(const LAS f32x4*)(row + 4 * i4);
#pragma unroll
            for (int e = 0; e < 4; ++e) { const int i = 4 * i4 + e; rank += ((v[e] > mine) || (v[e] == mine && i < lane)) ? 1 : 0; } }
        const bool sel = (rank < 16) && (lane <= c);
        const unsigned long long mk = __ballot(sel);
        wun |= mk;
        if (lane == 0) { selm[(8 * w + tt) * 2] = (unsigned)mk; selm[(8 * w + tt) * 2 + 1] = (unsigned)(mk >> 32); }
    }
    if (lane == 0) { wunl[2 * w] = (unsigned)wun; wunl[2 * w + 1] = (unsigned)(wun >> 32); }
    const unsigned long long mysel = (unsigned long long)selm[tq * 2] | ((unsigned long long)selm[tq * 2 + 1] << 32);
    __syncthreads();
    unsigned long long uni = 0ull;
#pragma unroll
    for (int i = 0; i < 8; ++i) uni |= (unsigned long long)wunl[2 * i] | ((unsigned long long)wunl[2 * i + 1] << 32);
    uni = ((unsigned long long)__builtin_amdgcn_readfirstlane((unsigned)(uni >> 32)) << 32) | (unsigned long long)__builtin_amdgcn_readfirstlane((unsigned)uni);

    mrow[0] = mrow[1] = -1e30f; lrow[0] = lrow[1] = 0.f;
    {
        int j = __builtin_ctzll(uni);
        tr = tile_load(PKS + (size_t)(64 * j) * NP, NP, VTS + 64 * j, T, tid);
        while (uni) {
            j = __builtin_ctzll(uni); uni &= uni - 1;
            tile_store(lds, buf, tr, tid); __syncthreads();
            if (uni) { const int jn = __builtin_ctzll(uni); tr = tile_load(PKS + (size_t)(64 * jn) * NP, NP, VTS + 64 * jn, T, tid); }
            if ((wun >> j) & 1ull) tile_compute<2>(lds, buf, 64 * j, t, Qf, sl2, mrow, lrow, O, ((mysel >> j) & 1ull) != 0ull, improw, 0, lane);
            buf ^= 1;
        }
    }
#pragma unroll
    for (int qb = 0; qb < 2; ++qb) { float l = lrow[qb]; l += __shfl_xor(l, 16); l += __shfl_xor(l, 32); const float inv = (l > 0.f ? 1.0f / l : 0.f) * gate[qb][1];
#pragma unroll
        for (int db = 0; db < 4; ++db) { out[qb][db] += inv * O[qb][db]; O[qb][db] = (f32x4){0.f, 0.f, 0.f, 0.f}; } }

    mrow[0] = mrow[1] = -1e30f; lrow[0] = lrow[1] = 0.f;
    {
        const int j0 = c >= 8 ? c - 8 : 0;
        tr = tile_load(PKW + (size_t)(64 * j0) * NP, NP, VTW + 64 * j0, T, tid);
        for (int j = j0; j <= c; ++j) {
            tile_store(lds, buf, tr, tid); __syncthreads();
            if (j < c) tr = tile_load(PKW + (size_t)(64 * (j + 1)) * NP, NP, VTW + 64 * (j + 1), T, tid);
            tile_compute<3>(lds, buf, 64 * j, t, Qf, sl2, mrow, lrow, O, true, improw, 0, lane);
            buf ^= 1;
        }
    }
    float ss = 0.f;
    bf16* OA = (bf16*)(ws + WS_OATT);
#pragma unroll
    for (int qb = 0; qb < 2; ++qb) { float l = lrow[qb]; l += __shfl_xor(l, 16); l += __shfl_xor(l, 32); const float inv = (l > 0.f ? 1.0f / l : 0.f) * gate[qb][2];
#pragma unroll
        for (int db = 0; db < 4; ++db) { const f32x4 o = out[qb][db] + inv * O[qb][db]; ss += (o.x * o.x + o.y * o.y) + (o.z * o.z + o.w * o.w);
            u32x2 pk; pk.x = pk2(o.x, o.y); pk.y = pk2(o.z, o.w);
            *(u32x2*)(OA + R * 512 + hk * 256 + (2 * qb + gl) * 64 + 16 * db + 4 * kq) = pk; } }
    ss += __shfl_xor(ss, 8); ss += __shfl_xor(ss, 16); ss += __shfl_xor(ss, 32);
    if (lane < 8) ((float*)(ws + WS_SSA))[R * 2 + hk] = ss;
    __syncthreads();
}


#define RLX_AGENT __ATOMIC_RELAXED, __HIP_MEMORY_SCOPE_AGENT
#define XB_TMO      128
#define XB_XCNT(j)  (256  + 64 * (j))
#define XB_XSUB(j)  (1280 + 64 * (j))
#define XB_XGEN(j)  (2304 + 64 * (j))
#define XB_TOP      3328
#define XB_TOPGEN   3392
#define XCD_BAR_WORDS 3456
#define XB_SPIN_CAP (1u << 18)

__device__ __forceinline__ unsigned xb_ld(unsigned* p)              { return __hip_atomic_load(p, __ATOMIC_RELAXED, __HIP_MEMORY_SCOPE_AGENT); }
__device__ __forceinline__ unsigned xb_add(unsigned* p, unsigned v) { return __hip_atomic_fetch_add(p, v, __ATOMIC_RELAXED, __HIP_MEMORY_SCOPE_AGENT); }
__device__ __forceinline__ unsigned xb_xcc_id() { return (unsigned)__builtin_amdgcn_s_getreg((3 << 11) | 20) & 0xFu; }
#define XB_SPIN(cond, bar) do { unsigned _sp = 0; while (cond) { __builtin_amdgcn_s_sleep(1); \
    if ((++_sp & 255u) == 0u) { if (xb_ld(&(bar)[XB_TMO])) break; if (_sp > XB_SPIN_CAP) { atomicAdd(&(bar)[XB_TMO], 1u); break; } } } } while (0)

struct XcdBarrier {
    unsigned* bar; unsigned x;
    volatile LAS unsigned* st;
};

__device__ __forceinline__ XcdBarrier xcd_barrier_post(unsigned* bar, volatile LAS unsigned* st) {
    XcdBarrier b; b.bar = bar; b.x = xb_xcc_id(); b.st = st;
    if (threadIdx.x == 0) (void)xb_add(&bar[XB_XCNT(b.x)], 1u);
    return b;
}
__device__ __forceinline__ void xcd_barrier_complete(unsigned* bar, unsigned x, unsigned& nloc, unsigned& nx) {
    const unsigned G = gridDim.x * gridDim.y * gridDim.z;
    unsigned sum, cnt, mine, sp = 0u;
    for (;;) {
        sum = 0u; cnt = 0u; mine = 0u;
#pragma unroll
        for (unsigned j = 0; j < 16; ++j) { const unsigned c = xb_ld(&bar[XB_XCNT(j)]); sum += c; cnt += (c > 0u) ? 1u : 0u; mine = (j == x) ? c : mine; }
        if (sum == G) break;
        __builtin_amdgcn_s_sleep(1);
        if ((++sp & 255u) == 0u) { if (xb_ld(&bar[XB_TMO])) break; if (sp > XB_SPIN_CAP) { atomicAdd(&bar[XB_TMO], 1u); break; } }
    }
    nloc = mine > 0u ? mine : 1u; nx = cnt > 0u ? cnt : 1u;
}

__device__ __forceinline__ void xcd_barrier(const XcdBarrier& b) {
    asm volatile("s_waitcnt vmcnt(0)" ::: "memory");
    __syncthreads();
    if (threadIdx.x == 0) {
        unsigned* bar = b.bar;
        __builtin_amdgcn_s_waitcnt(0);
        unsigned nloc = b.st[0], nx = b.st[1];
        if (nloc == 0u) { xcd_barrier_complete(bar, b.x, nloc, nx); b.st[0] = nloc; b.st[1] = nx; }
        const unsigned old = xb_add(&bar[XB_XSUB(b.x)], 1u);
        const unsigned gen = old / nloc;
        if (old + 1u == (gen + 1u) * nloc) {
            __builtin_amdgcn_fence(__ATOMIC_RELEASE, "agent");
            asm volatile("s_waitcnt vmcnt(0)" ::: "memory");
            const unsigned og = xb_add(&bar[XB_TOP], 1u);
            const unsigned tg = og / nx;
            if (og + 1u == (tg + 1u) * nx) xb_add(&bar[XB_TOPGEN], 1u);
            else XB_SPIN(xb_ld(&bar[XB_TOPGEN]) == tg, bar);
            __builtin_amdgcn_fence(__ATOMIC_ACQUIRE, "agent");
            xb_add(&bar[XB_XGEN(b.x)], 1u);
            asm volatile("s_waitcnt vmcnt(0)" ::: "memory");
        } else {
            XB_SPIN(xb_ld(&bar[XB_XGEN(b.x)]) == gen, bar);
            __builtin_amdgcn_fence(__ATOMIC_ACQUIRE, "agent");
            asm volatile("s_waitcnt vmcnt(0)" ::: "memory");
        }
    }
    __syncthreads();
}

constexpr int NPHASE = 11;
__global__ void __launch_bounds__(NWAVES * 64, 2) hymba_fwd(Args args) {
    extern __shared__ __attribute__((aligned(16))) unsigned char lds_raw[];
    LAS unsigned char* lds = (LAS unsigned char*)lds_raw;
    cg::grid_group grid = cg::this_grid();
    const int tid = threadIdx.x, lane = tid & 63, wave = __builtin_amdgcn_readfirstlane(tid >> 6);
    const int G = gridDim.x, bx = blockIdx.x;
    const int gw = bx * NWAVES + wave, NGW = G * NWAVES;
    unsigned char* ws = args.ws;
    const int lo = args.ph_lo, hi = args.ph_hi;
#define IN(k) (lo <= (k) && (k) < hi)
    if (tid < 16) ((LAS unsigned*)(lds + BARLDS_OFF))[tid] = 0u;
    __syncthreads();
    XcdBarrier bar = xcd_barrier_post((unsigned*)(ws + WS_CTL) + CW_BAR, (volatile LAS unsigned*)(lds + BARLDS_OFF));
#define SEAM(k) do { if (IN(k) && IN((k) + 1)) { if ((k) == 0) grid.sync(); else xcd_barrier(bar); } } while (0)

    if (IN(0)) {
        LAS float* scr = (LAS float*)(lds + wave * 16384);
        constexpr int I_IN = 16 * 96, I_OUT = 16 * 32, I_G = 16 * 88, I_DN = 44 * 32, I_C1 = 32 * 4;
        constexpr int NITEMS = I_IN + I_OUT + 2 * I_G + I_DN + 2 * I_C1;
        for (int it = gw; it < NITEMS; it += NGW) {
            int r = it;
            if (r < I_IN) { p0_transpose_item(args.in[2], D, NPROJ, (bf16*)(ws + WS_WIN), 0, scr, r, 96, lane); continue; } r -= I_IN;
            if (r < I_OUT) { p0_transpose_item(args.in[12], D, D, (bf16*)(ws + WS_WOUT), 0, scr, r, 32, lane); continue; } r -= I_OUT;
            if (r < I_G) { p0_transpose_item(args.in[14], D, DFF, (bf16*)(ws + WS_WGU), 0, scr, r, 88, lane); continue; } r -= I_G;
            if (r < I_G) { p0_transpose_item(args.in[15], D, DFF, (bf16*)(ws + WS_WGU), DFF, scr, r, 88, lane); continue; } r -= I_G;
            if (r < I_DN) { p0_transpose_item(args.in[18], DFF, D, (bf16*)(ws + WS_WDN), 0, scr, r, 32, lane); continue; } r -= I_DN;
            if (r < I_C1) { p0_transpose_item(args.in[4], 2048, 128, (bf16*)(ws + WS_WC1K), 0, scr, r, 4, lane); continue; } r -= I_C1;
            p0_transpose_item(args.in[7], 2048, 128, (bf16*)(ws + WS_WC1V), 0, scr, r, 4, lane);
        }
        for (int m = gw; m < M; m += NGW) rms_row_bf16(args.in[0] + (size_t)m * D, args.in[1], (bf16*)(ws + WS_XN) + (size_t)m * D, lane);
    }
    SEAM(0);
    if (IN(1)) {
        pg8::Gemm g{(const pg8::bf16_t*)(ws + WS_XN), (const pg8::bf16_t*)(ws + WS_WIN), M, NP, D}; pg8::StaticOrder S; S.init(M, NP, G, bx);
        pg8::EpiBf16 E{(pg8::bf16_t*)(ws + WS_P), NP, 0, 0};
        pg8::gemm_phase<pg8::EpiBf16, pg8::StaticOrder, true, true>(lds, g, S, E);
    }
    SEAM(1);
    if (IN(2)) {
        for (int it = bx; it < 256; it += G) compress_item(args, lds, it, tid);
        for (int it = bx; it < 2048; it += G) vtrans_item(args, lds, it, tid);
        for (int m = gw; m < M; m += NGW) conv_row(args, m, lane);
    }
    SEAM(2);
    if (IN(3)) {
        LAS int* ctl = (LAS int*)(lds + AL_CTL);
        for (;;) {
            if (tid == 0) ctl[0] = (int)atomicAdd((unsigned*)(ws + WS_CTL), 1u);
            __syncthreads();
            const int it = ctl[0];
            if (it >= 1024) break;
            attn_item(args, lds, it, tid);
        }
    }
    SEAM(3);
    if (IN(4)) {
        const bf16* OA = (const bf16*)(ws + WS_OATT); const float* ssa = (const float*)(ws + WS_SSA); bf16* MIX = (bf16*)(ws + WS_MIX); const float* gn = args.in[10];
        for (int m = gw; m < M; m += NGW) {
            const float rs = 1.0f / sqrtf((ssa[2 * m] + ssa[2 * m + 1]) * (1.f / 512.f) + EPS);
            const int ch = 8 * lane; const u32x4 v = *(const u32x4*)(OA + (size_t)m * 512 + ch);
            const f32x4 g0 = *(const f32x4*)(gn + ch), g1 = *(const f32x4*)(gn + ch + 4);
            u32x4 o; o.x = pk2(bf_lo(v.x) * rs * g0.x, bf_hi(v.x) * rs * g0.y); o.y = pk2(bf_lo(v.y) * rs * g0.z, bf_hi(v.y) * rs * g0.w);
            o.z = pk2(bf_lo(v.z) * rs * g1.x, bf_hi(v.z) * rs * g1.y); o.w = pk2(bf_lo(v.w) * rs * g1.z, bf_hi(v.w) * rs * g1.w);
            *(u32x4*)(MIX + (size_t)m * D + ch) = o;
        }
    }
    SEAM(4);
    if (IN(5)) {
        pg8::Gemm g{(const pg8::bf16_t*)(ws + WS_MIX), (const pg8::bf16_t*)(ws + WS_WOUT), M, D, D}; pg8::StaticOrder S; S.init(M, D, G, bx);
        pg8::EpiResF32 E{args.in[0], args.out, D};
        pg8::gemm_phase<pg8::EpiResF32, pg8::StaticOrder, true, true>(lds, g, S, E);
    }
    SEAM(5);
    if (IN(6)) {
        for (int m = gw; m < M; m += NGW) rms_row_bf16(args.out + (size_t)m * D, args.in[13], (bf16*)(ws + WS_XN) + (size_t)m * D, lane);
    }
    SEAM(6);
    if (IN(7)) {
        pg8::Gemm g{(const pg8::bf16_t*)(ws + WS_XN), (const pg8::bf16_t*)(ws + WS_WGU), M, NGU, D}; pg8::StaticOrder S; S.init(M, NGU, G, bx);
        pg8::EpiBf16 E{(pg8::bf16_t*)(ws + WS_GP), DFF, DFF, (size_t)(WS_UP - WS_GP) / 2};
        pg8::gemm_phase<pg8::EpiBf16, pg8::StaticOrder, true, true>(lds, g, S, E);
    }
    SEAM(7);
    if (IN(8)) {
        const bf16* GP = (const bf16*)(ws + WS_GP); bf16* UP = (bf16*)(ws + WS_UP); const float* cw = args.in[16]; const float* cb = args.in[17];
        for (int m = gw; m < M; m += NGW) {
            const int t = m & (T - 1); const bf16* gr = GP + (size_t)m * DFF;
            for (int ch = 8 * lane; ch < DFF; ch += 512) {
                const u32x4 g2 = *(const u32x4*)(gr + ch);
                const u32x4 g1 = t >= 1 ? *(const u32x4*)(gr - DFF + ch) : (u32x4){0u, 0u, 0u, 0u};
                const u32x4 g0 = t >= 2 ? *(const u32x4*)(gr - 2 * DFF + ch) : (u32x4){0u, 0u, 0u, 0u};
                const u32x4 uv = *(const u32x4*)(UP + (size_t)m * DFF + ch);
                float gt[8], uu[8];
#pragma unroll
                for (int e = 0; e < 4; ++e) {
                    const f32x2 w0 = *(const f32x2*)(cw + ch + 2 * e), w1 = *(const f32x2*)(cw + DFF + ch + 2 * e), w2 = *(const f32x2*)(cw + 2 * DFF + ch + 2 * e), bb = *(const f32x2*)(cb + ch + 2 * e);
                    gt[2 * e] = w0.x * bf_lo(g0[e]) + w1.x * bf_lo(g1[e]) + w2.x * bf_lo(g2[e]) + bb.x;
                    gt[2 * e + 1] = w0.y * bf_hi(g0[e]) + w1.y * bf_hi(g1[e]) + w2.y * bf_hi(g2[e]) + bb.y;
                    uu[2 * e] = bf_lo(uv[e]); uu[2 * e + 1] = bf_hi(uv[e]);
                }
                u32x4 o;
#pragma unroll
                for (int e = 0; e < 4; ++e) { const float a0 = gt[2 * e] * sigmoidf_(gt[2 * e]) * uu[2 * e], a1 = gt[2 * e + 1] * sigmoidf_(gt[2 * e + 1]) * uu[2 * e + 1]; o[e] = pk2(a0, a1); }
                *(u32x4*)(UP + (size_t)m * DFF + ch) = o;
            }
        }
    }
    SEAM(8);
    if (IN(9)) {
        pg8::Gemm g{(const pg8::bf16_t*)(ws + WS_UP), (const pg8::bf16_t*)(ws + WS_WDN), M, D, DFF}; pg8::StaticOrder S; S.init(M, D, G, bx);
        pg8::EpiResF32 E{args.out, args.out, D};
        pg8::gemm_phase<pg8::EpiResF32, pg8::StaticOrder, true, true>(lds, g, S, E);
    }
    SEAM(9);
    if (IN(10)) {
        const float* gn = args.in[19];
        for (int m = gw; m < M; m += NGW) {
            f32x4* xr = (f32x4*)(args.out + (size_t)m * D) + lane; const f32x4* gr = (const f32x4*)gn + lane;
            f32x4 v[4]; float s = 0.f;
#pragma unroll
            for (int j = 0; j < 4; ++j) { v[j] = xr[64 * j]; s += (v[j].x * v[j].x + v[j].y * v[j].y) + (v[j].z * v[j].z + v[j].w * v[j].w); }
            const float rs = 1.0f / sqrtf(wave_sum(s) * (1.f / D) + EPS);
#pragma unroll
            for (int j = 0; j < 4; ++j) xr[64 * j] = v[j] * rs * gr[64 * j];
        }
    }
#undef IN
#undef SEAM
}

extern "C" void kernel_launch(void* const* d_in, const int* in_sizes, int n_in, void* d_out, int out_size, void* d_ws, size_t ws_size, hipStream_t stream) {
    static int grid = 0;
    if (grid == 0) {
        if (n_in != 20 || in_sizes[0] != M * D || out_size != M * D || ws_size < WS_END) { fprintf(stderr, "kernel_launch: unexpected sizes n_in %d in0 %d out %d ws %zu\n", n_in, n_in > 0 ? in_sizes[0] : -1, out_size, ws_size); grid = -1; return; }
        int dev = 0, cus = 0, per_cu = 0;
        hipGetDevice(&dev); hipDeviceGetAttribute(&cus, hipDeviceAttributeMultiprocessorCount, dev);
        if (hipFuncSetAttribute((const void*)hymba_fwd, hipFuncAttributeMaxDynamicSharedMemorySize, LDS_BYTES) != hipSuccess) { fprintf(stderr, "kernel_launch: hipFuncSetAttribute failed\n"); grid = -1; return; }
        if (hipOccupancyMaxActiveBlocksPerMultiprocessor(&per_cu, (const void*)hymba_fwd, NWAVES * 64, LDS_BYTES) != hipSuccess || per_cu < 1) { fprintf(stderr, "kernel_launch: occupancy query says %d\n", per_cu); per_cu = 1; }
        (void)hipGetLastError();
        grid = cus * per_cu;
    }
    if (grid < 0) return;
    if (hipMemsetAsync((char*)d_ws + WS_CTL, 0, CTL_ZERO_BYTES, stream) != hipSuccess) { fprintf(stderr, "kernel_launch: memset failed\n"); return; }
    Args a{};
    for (int i = 0; i < 20; ++i) a.in[i] = (const float*)d_in[i];
    a.out = (float*)d_out; a.ws = (unsigned char*)d_ws;
#if MK_N_LAUNCHES == 1
    a.ph_lo = 0; a.ph_hi = NPHASE;
    void* kargs[] = {&a};
    hipError_t e = hipLaunchCooperativeKernel((const void*)hymba_fwd, dim3(grid), dim3(NWAVES * 64), kargs, LDS_BYTES, stream);
    if (e != hipSuccess) fprintf(stderr, "cooperative launch failed: %s (grid %d)\n", hipGetErrorString(e), grid);
#else
    for (int p = 0; p < NPHASE; ++p) { a.ph_lo = p; a.ph_hi = p + 1; hipLaunchKernelGGL(hymba_fwd, dim3(grid), dim3(NWAVES * 64), LDS_BYTES, stream, a); }
#endif
}
```

```cpp
#include <hip/hip_runtime.h>
#include <hip/hip_cooperative_groups.h>
#include <cstdio>
#include <cstdint>
namespace cg = cooperative_groups;
namespace pg8 {
#define PG8_LAS __attribute__((address_space(3)))
typedef unsigned short bf16_t;
typedef short bf16x8 __attribute__((ext_vector_type(8)));
typedef float f32x4 __attribute__((ext_vector_type(4)));
typedef unsigned u32x4 __attribute__((ext_vector_type(4)));
constexpr int BM = 256, BK = 64, HALF = 128, HTB = HALF * BK * 2  , STAGE_BYTES = 8 * HTB, NXCD = 8, WGM = 8;

__host__ __device__ __forceinline__ int lds_byte(int r, int c) { const int st = (r >> 4) * 2 + (c >> 5), rr = r & 15, cc = c & 31, ob = rr * 64 + cc * 2; return st * 1024 + (ob ^ (((ob >> 9) & 1) << 5)); }
__host__ __device__ __forceinline__ void stage_rc(int b, int& R, int& C) { const int st = b / 1024, sb = b % 1024, swz = sb ^ (((sb >> 9) & 1) << 5); R = (st >> 1) * 16 + swz / 64; C = (st & 1) * 32 + (swz % 64) / 2; }
__host__ __device__ __forceinline__ int perm32(int rho) { const int n = rho >> 4, i = rho & 15; return 8 * (i >> 2) + 4 * n + (i & 3); }

struct Unit { int pm, pn; };
struct Gemm { const bf16_t* A; const bf16_t* Bt; int M, N, K; };

struct StaticOrder {
    int nM, nN, nwg, G, c;
    __host__ __device__ void init(int M, int N, int G_, int c_) { nM = M / BM; nN = N / BM; nwg = nM * nN; G = G_; c = c_; }
    __host__ __device__ bool next(int i, Unit& u) const {
        const long L = (long)i * G + c; if (L >= nwg) return false;
        int wgid = (int)L; { const int q = nwg / NXCD, r = nwg % NXCD, xcd = wgid % NXCD, off = wgid / NXCD; wgid = (xcd < r ? xcd * (q + 1) : r * (q + 1) + (xcd - r) * q) + off; }
        const int nig = WGM * nN, gid = wgid / nig, fm = gid * WGM, gsz = (nM - fm) < WGM ? (nM - fm) : WGM;
        u.pm = fm + ((wgid % nig) % gsz); u.pn = (wgid % nig) / gsz; return true;
    }
    __device__ __forceinline__ void a_ready(const Unit&) const {}
    __device__ __forceinline__ void done(const Unit&) const {}
};

__device__ __forceinline__ unsigned cvt_pk_bf16(float lo, float hi) { unsigned r; asm volatile("v_cvt_pk_bf16_f32 %0, %1, %2" : "=v"(r) : "v"(lo), "v"(hi)); return r; }

struct EpiBf16 {
    static constexpr bool PERM = true, AFTER_DRAIN = false;
    bf16_t* O; int ldc; int split_cols; size_t split_stride;
    __device__ __forceinline__ void operator()(const f32x4 (&acc)[2][2][4][2], const Unit& u, int wr, int wc, int fr, int fq) const {
        const int row0 = u.pm * BM + wr * 64 + fr; int colt = u.pn * BM; bf16_t* base = O;
        if (split_cols) { const int t = colt / split_cols; base += (size_t)t * split_stride; colt -= t * split_cols; }
        const int col0 = colt + wc * 32 + 8 * fq;
#pragma unroll
        for (int ai = 0; ai < 2; ++ai)
#pragma unroll
            for (int m = 0; m < 4; ++m) { bf16_t* rowp = base + (size_t)(row0 + ai * HALF + m * 16) * ldc + col0;
#pragma unroll
                for (int bj = 0; bj < 2; ++bj) { const f32x4 v0 = acc[ai][bj][m][0], v1 = acc[ai][bj][m][1];
                    u32x4 w; w.x = cvt_pk_bf16(v0[0], v0[1]); w.y = cvt_pk_bf16(v0[2], v0[3]); w.z = cvt_pk_bf16(v1[0], v1[1]); w.w = cvt_pk_bf16(v1[2], v1[3]);
                    *(u32x4*)(rowp + bj * HALF) = w; } }
    }
};
struct EpiResF32 {
    static constexpr bool PERM = false, AFTER_DRAIN = false;
    const float* base; float* out; int ldc;
    __device__ __forceinline__ void operator()(const f32x4 (&acc)[2][2][4][2], const Unit& u, int wr, int wc, int fr, int fq) const {
        const int col0 = u.pn * BM + wc * 32 + 4 * fq;
#pragma unroll
        for (int ai = 0; ai < 2; ++ai)
#pragma unroll
            for (int m = 0; m < 4; ++m) { const size_t off = (size_t)(u.pm * BM + ai * HALF + wr * 64 + m * 16 + fr) * ldc + col0;
#pragma unroll
                for (int bj = 0; bj < 2; ++bj)
#pragma unroll
                    for (int n = 0; n < 2; ++n) { const f32x4 bs = *(const f32x4*)(base + off + bj * HALF + n * 16); *(f32x4*)(out + off + bj * HALF + n * 16) = bs + acc[ai][bj][m][n]; } }
    }
};


struct EpiFfn {
    static constexpr bool PERM = true, AFTER_DRAIN = false;
    bf16_t* ACT; const float* cw; const float* cb; int Mrows; int DFFc; int Tseq;
    __device__ __forceinline__ void operator()(const f32x4 (&acc)[2][2][4][2], const Unit& u, int wr, int wc, int fr, int fq) const {
        const int ch0 = u.pn * 128 + wc * 32 + 8 * fq;
        const int rbase = 252 * u.pm - 2 + 126 * wr + 8 * fr;
        f32x4 w0[2], w1[2], w2[2], bb[2];
#pragma unroll
        for (int n = 0; n < 2; ++n) { w0[n] = *(const f32x4*)(cw + ch0 + 4 * n); w1[n] = *(const f32x4*)(cw + DFFc + ch0 + 4 * n); w2[n] = *(const f32x4*)(cw + 2 * DFFc + ch0 + 4 * n); bb[n] = *(const f32x4*)(cb + ch0 + 4 * n); }
        float p6[2][4], p7[2][4];
#pragma unroll
        for (int n = 0; n < 2; ++n)
#pragma unroll
            for (int i = 0; i < 4; ++i) { p7[n][i] = __shfl_up(acc[1][0][3][n][i], 1, 16); p6[n][i] = __shfl_up(acc[1][0][2][n][i], 1, 16); }
#pragma unroll
        for (int k = 0; k < 8; ++k) {
            const int r = rbase + k, tk = r & (Tseq - 1);
            const bool ok = (8 * fr + k >= 2) && (r < Mrows);
            float o[2][4];
#pragma unroll
            for (int n = 0; n < 2; ++n)
#pragma unroll
                for (int i = 0; i < 4; ++i) {
                    const float gk = acc[k >> 2][0][k & 3][n][i];
                    float gm1 = (k >= 1) ? acc[(k >= 1 ? k - 1 : 0) >> 2][0][(k >= 1 ? k - 1 : 0) & 3][n][i] : p7[n][i];
                    float gm2 = (k >= 2) ? acc[(k >= 2 ? k - 2 : 0) >> 2][0][(k >= 2 ? k - 2 : 0) & 3][n][i] : (k == 1 ? p7[n][i] : p6[n][i]);
                    gm1 = tk >= 1 ? gm1 : 0.f; gm2 = tk >= 2 ? gm2 : 0.f;
                    const float gt = w0[n][i] * gm2 + w1[n][i] * gm1 + w2[n][i] * gk + bb[n][i];
                    o[n][i] = gt * (1.0f / (1.0f + __expf(-gt))) * acc[k >> 2][1][k & 3][n][i];
                }
            u32x4 w; w.x = cvt_pk_bf16(o[0][0], o[0][1]); w.y = cvt_pk_bf16(o[0][2], o[0][3]); w.z = cvt_pk_bf16(o[1][0], o[1][1]); w.w = cvt_pk_bf16(o[1][2], o[1][3]);
            if (ok) *(u32x4*)(ACT + (size_t)r * DFFc + ch0) = w;
        }
    }
};

template <class Epi, class Sched, bool ALIGN_EPI = false, bool SP2 = false, bool AMAP = false>
__device__ __forceinline__ void gemm_phase(PG8_LAS unsigned char* lds, const Gemm g, const Sched& S, const Epi& E) {
    const int tid = threadIdx.x, wid = __builtin_amdgcn_readfirstlane(tid >> 6), lane = tid & 63, wr = wid >> 2, wc = wid & 3, fr = lane & 15, fq = lane >> 4;
    const int K = g.K, nt = K / BK;
    unsigned voffA[2], voffB[2];
#pragma unroll
    for (int i = 0; i < 2; ++i) { int R, C; stage_rc(tid * 16 + i * 8192, R, C); const int Rb = Epi::PERM ? ((R & ~31) + perm32(R & 31)) : R;
        const int Ra = AMAP ? (126 * (R >> 6) + 8 * (R & 15) + ((R >> 4) & 3)) : R; voffA[i] = (unsigned)(Ra * K + C) * 2u; voffB[i] = (unsigned)(Rb * K + C) * 2u; }
    const size_t kstep = (size_t)(BK * 2);
    const size_t hstep = (size_t)HALF * K * 2;
    const size_t tstep = 2 * hstep;
    const size_t hstepA = AMAP ? (size_t)4 * K * 2 : hstep;
#define PG8_AOFF(pm) (AMAP ? ((ptrdiff_t)252 * (pm) - 2) * (ptrdiff_t)K * 2 : (ptrdiff_t)((size_t)(pm) * tstep))
    const unsigned ldsw = (unsigned)wid * 1024u;
    const int aoff = lds_byte(wr * 64 + fr, fq * 8), boff = lds_byte(wc * 32 + fr, fq * 8);
#define PG8_SA(b, h) (((b) * 2 + (h)) * HTB)
#define PG8_SB(b, h) ((4 + (b) * 2 + (h)) * HTB)
#define PG8_STAGE(bufoff, gbase, voff) do { _Pragma("unroll") for (int _i = 0; _i < 2; ++_i) \
        __builtin_amdgcn_global_load_lds((const unsigned*)((const char*)(gbase) + (voff)[_i]), (PG8_LAS unsigned*)(lds + (bufoff) + ldsw + _i * 8192), 16, 0, 0); } while (0)
#define PG8_LDA(dst, b, h) do { _Pragma("unroll") for (int m = 0; m < 4; ++m) _Pragma("unroll") for (int k = 0; k < 2; ++k) dst[m][k] = *(const PG8_LAS bf16x8*)(lds + PG8_SA(b, h) + aoff + m * 2048 + k * 1024); } while (0)
#define PG8_LDB(dst, b, h) do { _Pragma("unroll") for (int n = 0; n < 2; ++n) _Pragma("unroll") for (int k = 0; k < 2; ++k) dst[n][k] = *(const PG8_LAS bf16x8*)(lds + PG8_SB(b, h) + boff + n * 2048 + k * 1024); } while (0)
#define PG8_MMA(ai, bj, At, Bt) do { __builtin_amdgcn_s_setprio(1); _Pragma("unroll") for (int m = 0; m < 4; ++m) _Pragma("unroll") for (int n = 0; n < 2; ++n) _Pragma("unroll") for (int k = 0; k < 2; ++k) \
        acc[ai][bj][m][n] = __builtin_amdgcn_mfma_f32_16x16x32_bf16(Bt[n][k], At[m][k], acc[ai][bj][m][n], 0, 0, 0); __builtin_amdgcn_s_setprio(0); } while (0)
#define PG8_WAIT_V(n) asm volatile("s_waitcnt vmcnt(" #n ")" ::: "memory")
#define PG8_WAIT_L(n) asm volatile("s_waitcnt lgkmcnt(" #n ")" ::: "memory")
#define PG8_BAR __builtin_amdgcn_s_barrier()
#define PG8_SCHED __builtin_amdgcn_sched_barrier(0)
    Unit cur, nxt; int ui = 0;
    if (!S.next(0, cur)) return;
    f32x4 acc[2][2][4][2];
#pragma unroll
    for (int a = 0; a < 2; ++a)
#pragma unroll
        for (int b = 0; b < 2; ++b)
#pragma unroll
            for (int m = 0; m < 4; ++m)
#pragma unroll
                for (int n = 0; n < 2; ++n) acc[a][b][m][n] = (f32x4){0.f, 0.f, 0.f, 0.f};
    bf16x8 At[4][2], B0[2][2], B1[2][2];
    const char* cA = (const char*)g.A + PG8_AOFF(cur.pm); const char* cB = (const char*)g.Bt + (size_t)cur.pn * tstep;
    S.a_ready(cur);
    if constexpr (SP2) {
        PG8_STAGE(PG8_SB(0, 0), cB, voffB); PG8_STAGE(PG8_SB(0, 1), cB + hstep, voffB); PG8_STAGE(PG8_SA(0, 0), cA, voffA); PG8_STAGE(PG8_SA(0, 1), cA + hstepA, voffA);
        if (wr == 1) PG8_BAR;
        PG8_WAIT_V(2); PG8_BAR;
        PG8_STAGE(PG8_SB(1, 0), cB + kstep, voffB); PG8_STAGE(PG8_SA(1, 0), cA + kstep, voffA); PG8_STAGE(PG8_SB(1, 1), cB + hstep + kstep, voffB);
        PG8_WAIT_V(6); PG8_BAR;
    } else {
        PG8_STAGE(PG8_SB(0, 0), cB, voffB); PG8_STAGE(PG8_SA(0, 0), cA, voffA); PG8_STAGE(PG8_SB(0, 1), cB + hstep, voffB); PG8_STAGE(PG8_SA(0, 1), cA + hstepA, voffA);
        if (wr == 1) PG8_BAR;
        PG8_WAIT_V(4); PG8_BAR;
        PG8_STAGE(PG8_SB(1, 0), cB + kstep, voffB); PG8_STAGE(PG8_SA(1, 0), cA + kstep, voffA); PG8_STAGE(PG8_SB(1, 1), cB + hstep + kstep, voffB);
        PG8_WAIT_V(6); PG8_BAR;
    }
    for (;;) {
        const bool has_next = S.next(ui + 1, nxt);
        const char* nA = has_next ? (const char*)g.A + PG8_AOFF(nxt.pm) : cA; const char* nB = has_next ? (const char*)g.Bt + (size_t)nxt.pn * tstep : cB;
        for (int t = 0; t < nt; t += 2) {
            const bool last = (t == nt - 2);
            const char* a1 = cA + (size_t)(t + 1) * kstep;
            const char* a2 = last ? nA : cA + (size_t)(t + 2) * kstep; const char* b2 = last ? nB : cB + (size_t)(t + 2) * kstep;
            const char* a3 = a2 + kstep; const char* b3 = b2 + kstep;
            if (last && has_next) S.a_ready(nxt);
            if constexpr (SP2) {
            PG8_LDB(B0, 0, 0); PG8_LDB(B1, 0, 1); PG8_SCHED; PG8_LDA(At, 0, 0); PG8_STAGE(PG8_SA(1, 1), a1 + hstepA, voffA);
            PG8_WAIT_V(8); PG8_WAIT_L(0); PG8_BAR; PG8_MMA(0, 0, At, B0); PG8_MMA(0, 1, At, B1); PG8_BAR; PG8_SCHED;
            PG8_LDA(At, 0, 1); PG8_STAGE(PG8_SB(0, 0), b2, voffB); PG8_STAGE(PG8_SB(0, 1), b2 + hstep, voffB); PG8_STAGE(PG8_SA(0, 0), a2, voffA);
            PG8_WAIT_V(8); PG8_WAIT_L(0); PG8_BAR; PG8_MMA(1, 0, At, B0); PG8_MMA(1, 1, At, B1); PG8_BAR; PG8_SCHED;
            PG8_LDB(B0, 1, 0); PG8_LDB(B1, 1, 1); PG8_SCHED; PG8_LDA(At, 1, 0); PG8_STAGE(PG8_SA(0, 1), a2 + hstepA, voffA);
            PG8_WAIT_V(8); PG8_WAIT_L(0); PG8_BAR; PG8_MMA(0, 0, At, B0); PG8_MMA(0, 1, At, B1); PG8_BAR; PG8_SCHED;
            PG8_LDA(At, 1, 1); PG8_STAGE(PG8_SB(1, 0), b3, voffB); PG8_STAGE(PG8_SB(1, 1), b3 + hstep, voffB); PG8_STAGE(PG8_SA(1, 0), a3, voffA);
            PG8_WAIT_V(8); PG8_WAIT_L(0); PG8_BAR; PG8_MMA(1, 0, At, B0); PG8_MMA(1, 1, At, B1); PG8_BAR; PG8_SCHED;
            } else {
            PG8_LDB(B0, 0, 0); PG8_SCHED; PG8_LDA(At, 0, 0); PG8_STAGE(PG8_SA(1, 1), a1 + hstepA, voffA);
            PG8_WAIT_L(8); PG8_BAR; PG8_WAIT_L(0); PG8_MMA(0, 0, At, B0); PG8_BAR; PG8_SCHED;
            PG8_LDB(B1, 0, 1); PG8_STAGE(PG8_SB(0, 0), b2, voffB);
            PG8_BAR; PG8_WAIT_L(0); PG8_MMA(0, 1, At, B1); PG8_BAR;
            PG8_LDA(At, 0, 1); PG8_STAGE(PG8_SA(0, 0), a2, voffA);
            PG8_BAR; PG8_WAIT_L(0); PG8_MMA(1, 0, At, B0); PG8_BAR; PG8_SCHED;
            PG8_STAGE(PG8_SB(0, 1), b2 + hstep, voffB);
            PG8_WAIT_V(6); PG8_BAR; PG8_MMA(1, 1, At, B1); PG8_BAR;
            PG8_LDB(B0, 1, 0); PG8_SCHED; PG8_LDA(At, 1, 0); PG8_STAGE(PG8_SA(0, 1), a2 + hstepA, voffA);
            PG8_WAIT_L(8); PG8_BAR; PG8_WAIT_L(0); PG8_MMA(0, 0, At, B0); PG8_BAR; PG8_SCHED;
            PG8_LDB(B1, 1, 1); PG8_STAGE(PG8_SB(1, 0), b3, voffB);
            PG8_BAR; PG8_WAIT_L(0); PG8_MMA(0, 1, At, B1); PG8_BAR;
            PG8_LDA(At, 1, 1); PG8_STAGE(PG8_SA(1, 0), a3, voffA);
            PG8_BAR; PG8_WAIT_L(0); PG8_MMA(1, 0, At, B0); PG8_BAR; PG8_SCHED;
            PG8_STAGE(PG8_SB(1, 1), b3 + hstep, voffB);
            PG8_WAIT_V(6); PG8_BAR; PG8_MMA(1, 1, At, B1); PG8_BAR;
            }
        }
        if constexpr (ALIGN_EPI) { if (wr == 0) PG8_BAR; }
        if constexpr (!Epi::AFTER_DRAIN) { E(acc, cur, wr, wc, fr, fq); S.done(cur); }
        if (!has_next) break;
#pragma unroll
        for (int a = 0; a < 2; ++a)
#pragma unroll
            for (int b = 0; b < 2; ++b)
#pragma unroll
                for (int m = 0; m < 4; ++m)
#pragma unroll
                    for (int n = 0; n < 2; ++n) acc[a][b][m][n] = (f32x4){0.f, 0.f, 0.f, 0.f};
        cur = nxt; cA = nA; cB = nB; ++ui;
        if constexpr (ALIGN_EPI) { if (wr == 1) PG8_BAR; }
    }
    PG8_WAIT_V(0);
    if constexpr (!ALIGN_EPI) { if (wr == 0) PG8_BAR; }
    PG8_BAR;
    if constexpr (Epi::AFTER_DRAIN) { E.fused(acc, cur, wr, wc, fr, fq, lds, wid, lane); S.done(cur); }
#undef PG8_SA
#undef PG8_AOFF
#undef PG8_SB
#undef PG8_STAGE
#undef PG8_LDA
#undef PG8_LDB
#undef PG8_MMA
#undef PG8_WAIT_V
#undef PG8_WAIT_L
#undef PG8_BAR
#undef PG8_SCHED
}
}

#ifndef MK_N_LAUNCHES
#define MK_N_LAUNCHES 1
#endif
constexpr int NWAVES = 8;
constexpr int BATCH = 8, T = 4096, D = 1024, M = BATCH * T;
constexpr int NPROJ = 2840, NP = 3072;
constexpr int DFF = 2816, NGU = 2 * DFF;
constexpr int COL_Q = 0, COL_KC = 512, COL_VC = 640, COL_KS = 768, COL_VS = 896, COL_KW = 1024, COL_VW = 1152, COL_G = 1280, COL_BG = 1304, COL_CG = 1816, COL_U = 2328;
constexpr float EPS = 1e-6f;
constexpr float LOG2E = 1.4426950408889634f;

constexpr size_t MiB = 1u << 20;
constexpr size_t WS_CTL = 0;
constexpr size_t WS_WIN = 2 * MiB, WS_WOUT = 8 * MiB, WS_WGU = 10 * MiB, WS_WDN = 21 * MiB;
constexpr size_t WS_WC1K = 27 * MiB, WS_WC1V = 27 * MiB + 512 * 1024;
constexpr size_t WS_KCMP = 28 * MiB, WS_VCMPT = 28 * MiB + 512 * 1024, WS_SSA = 29 * MiB;
constexpr size_t WS_XN = 32 * MiB, WS_MIX = 96 * MiB, WS_P = 160 * MiB;
constexpr size_t WS_VTS = 352 * MiB, WS_VTW = 360 * MiB, WS_OATT = 368 * MiB;
constexpr size_t WS_ACT = 160 * MiB, WS_END = 400 * MiB;
static_assert(WS_P + (size_t)M * NP * 2 <= WS_VTS && WS_ACT + (size_t)M * DFF * 2 <= WS_END && WS_OATT + (size_t)M * 512 * 2 <= WS_END, "ws map");

constexpr int CW_BAR = 4096;
constexpr size_t CTL_ZERO_BYTES = 65536;
constexpr int RING_BYTES = 131072;
constexpr int BARLDS_OFF = RING_BYTES + 512;
constexpr int LDS_BYTES = 147456;

#define LAS __attribute__((address_space(3)))
typedef unsigned short bf16;
typedef unsigned u32x4 __attribute__((ext_vector_type(4)));
typedef unsigned u32x2 __attribute__((ext_vector_type(2)));
typedef float f32x4 __attribute__((ext_vector_type(4)));
typedef float f32x2 __attribute__((ext_vector_type(2)));
typedef short bf16x8 __attribute__((ext_vector_type(8)));
typedef short s16x4 __attribute__((ext_vector_type(4)));
typedef __bf16 bf16x2_t __attribute__((ext_vector_type(2)));

__device__ __forceinline__ unsigned pk2(float lo, float hi) { f32x2 v = {lo, hi}; bf16x2_t b = __builtin_convertvector(v, bf16x2_t); return __builtin_bit_cast(unsigned, b); }
__device__ __forceinline__ float bf_lo(unsigned u) { return __uint_as_float(u << 16); }
__device__ __forceinline__ float bf_hi(unsigned u) { return __uint_as_float(u & 0xffff0000u); }
__device__ __forceinline__ float bf1(bf16 u) { return __uint_as_float((unsigned)u << 16); }
__device__ __forceinline__ float wave_sum(float v) {
#pragma unroll
    for (int o = 1; o < 64; o <<= 1) v += __shfl_xor(v, o);
    return v;
}
__device__ __forceinline__ float sigmoidf_(float x) { return 1.0f / (1.0f + __expf(-x)); }

struct Args { const float* in[20]; float* out; unsigned char* ws; int ph_lo, ph_hi; };

__device__ __forceinline__ void p0_transpose_item(const float* W, int K, int Nsrc, bf16* WT, int row_off, LAS float* scr, int item, int nblk, int lane) {
    const int kb = item / nblk, nb = item % nblk, k0 = 64 * kb, n0 = 32 * nb;
    const int n = n0 + (lane & 31);
#pragma unroll 8
    for (int i = 0; i < 32; ++i) { const int kk = 2 * i + (lane >> 5); scr[kk * 33 + (lane & 31)] = (n < Nsrc) ? W[(size_t)(k0 + kk) * Nsrc + n] : 0.f; }
    asm volatile("s_waitcnt lgkmcnt(0)" ::: "memory");
    const int c = lane & 7;
#pragma unroll
    for (int j = 0; j < 4; ++j) { const int nn = (lane >> 3) + 8 * j; const LAS float* s = scr + (8 * c) * 33 + nn;
        u32x4 o; o.x = pk2(s[0 * 33], s[1 * 33]); o.y = pk2(s[2 * 33], s[3 * 33]); o.z = pk2(s[4 * 33], s[5 * 33]); o.w = pk2(s[6 * 33], s[7 * 33]);
        *(u32x4*)(WT + (size_t)(row_off + n0 + nn) * K + k0 + 8 * c) = o; }
    asm volatile("s_waitcnt lgkmcnt(0)" ::: "memory");
}
__device__ __forceinline__ void rms_row_bf16(const float* xrow, const float* g, bf16* orow, int lane) {
    const f32x4* xr = (const f32x4*)xrow + lane; const f32x4* gr = (const f32x4*)g + lane;
    f32x4 v[4]; float s = 0.f;
#pragma unroll
    for (int j = 0; j < 4; ++j) { v[j] = xr[64 * j]; s += (v[j].x * v[j].x + v[j].y * v[j].y) + (v[j].z * v[j].z + v[j].w * v[j].w); }
    const float rs = 1.0f / sqrtf(wave_sum(s) * (1.f / D) + EPS);
    u32x2* o8 = (u32x2*)orow + lane;
#pragma unroll
    for (int j = 0; j < 4; ++j) { const f32x4 gg = gr[64 * j]; u32x2 o; o.x = pk2(v[j].x * rs * gg.x, v[j].y * rs * gg.y); o.y = pk2(v[j].z * rs * gg.z, v[j].w * rs * gg.w); o8[64 * j] = o; }
}

__device__ __forceinline__ float gelu_tanh(float x) { const float u = 0.7978845608028654f * (x + 0.044715f * x * x * x); return 0.5f * x * (1.0f + tanhf(u)); }

__device__ __forceinline__ void compress_item(const Args& a, LAS unsigned char* lds, int item, int tid) {
    const int lane = tid & 63, w = __builtin_amdgcn_readfirstlane(tid >> 6), r16 = lane & 15, kq = lane >> 4;
    const int kv = item >> 7, b = (item >> 4) & 7, h = (item >> 3) & 1, ib = item & 7;
    unsigned char* ws = a.ws;
    const bf16* P = (const bf16*)(ws + WS_P);
    const bf16* W1T = (const bf16*)(ws + (kv ? WS_WC1V : WS_WC1K));
    const float* pos = a.in[kv ? 6 : 3];
    const float* w1 = a.in[kv ? 7 : 4];
    const float* w2 = a.in[kv ? 8 : 5];
    LAS unsigned char* Al = lds;
    LAS float* hid = (LAS float*)(lds + 67584);
    LAS float* bpart = (LAS float*)(lds + 67584 + 16512);
    const int col0 = (kv ? COL_VC : COL_KC) + h * 64;
    for (int idx = tid; idx < 528 * 8; idx += 512) {
        const int tau = idx >> 3, c = idx & 7; int tok = 512 * ib + tau; tok = tok < T ? tok : T - 1;
        const u32x4 v = *(const u32x4*)(P + (size_t)(b * T + tok) * NP + col0 + 8 * c);
        *(LAS u32x4*)(Al + tau * 128 + ((c ^ ((tau >> 4) & 7)) << 4)) = v;
    }
    {
        const int n = tid & 127, part = tid >> 7; float s = 0.f;
#pragma unroll 8
        for (int k = 0; k < 512; ++k) { const int kk = part * 512 + k; s += pos[kk] * w1[(size_t)kk * 128 + n]; }
        bpart[part * 128 + n] = s;
    }
    __syncthreads();
    f32x4 acc0 = {0.f, 0.f, 0.f, 0.f}, acc1 = {0.f, 0.f, 0.f, 0.f};
    const bf16* wrow = W1T + (size_t)(16 * w + r16) * 2048 + 8 * kq;
#pragma unroll 8
    for (int s = 0; s < 64; ++s) {
        const bf16x8 af = *(const bf16x8*)(wrow + 32 * s);
        const int l = s >> 1, c = (s & 1) * 4 + kq;
        const int tau0 = 16 * r16 + l, tau1 = tau0 + 256;
        const bf16x8 b0 = *(const LAS bf16x8*)(Al + tau0 * 128 + ((c ^ ((tau0 >> 4) & 7)) << 4));
        const bf16x8 b1 = *(const LAS bf16x8*)(Al + tau1 * 128 + ((c ^ ((tau1 >> 4) & 7)) << 4));
        acc0 = __builtin_amdgcn_mfma_f32_16x16x32_bf16(af, b0, acc0, 0, 0, 0);
        acc1 = __builtin_amdgcn_mfma_f32_16x16x32_bf16(af, b1, acc1, 0, 0, 0);
    }
#pragma unroll
    for (int j = 0; j < 4; ++j) { const int n = 16 * w + 4 * kq + j; const float bs = (bpart[n] + bpart[128 + n]) + (bpart[256 + n] + bpart[384 + n]);
        hid[r16 * 129 + n] = gelu_tanh(acc0[j] + bs); hid[(16 + r16) * 129 + n] = gelu_tanh(acc1[j] + bs); }
    __syncthreads();
    {
        const int i = tid >> 4, d4 = (tid & 15) * 4; f32x4 o = {0.f, 0.f, 0.f, 0.f};
#pragma unroll 8
        for (int n = 0; n < 128; ++n) { const float hv = hid[i * 129 + n]; const f32x4 wv = *(const f32x4*)(w2 + n * 64 + d4); o += hv * wv; }
        const int ig = 32 * ib + i;
        if (ig == 255) o = (f32x4){0.f, 0.f, 0.f, 0.f};
        if (kv == 0) { bf16* K = (bf16*)(ws + WS_KCMP); u32x2 pk; pk.x = pk2(o.x, o.y); pk.y = pk2(o.z, o.w); *(u32x2*)(K + ((size_t)(b * 2 + h) * 256 + ig) * 64 + d4) = pk; }
        else { bf16* Vt = (bf16*)(ws + WS_VCMPT);
#pragma unroll
            for (int e = 0; e < 4; ++e) Vt[((size_t)(b * 2 + h) * 64 + d4 + e) * 256 + ig] = (bf16)(pk2(o[e], 0.f) & 0xffffu); }
    }
    __syncthreads();
}

__device__ __forceinline__ void vtrans_item(const Args& a, LAS unsigned char* lds, int item, int tid) {
    const int which = item >> 10, b = (item >> 7) & 7, hk = (item >> 6) & 1, tt = item & 63;
    const bf16* P = (const bf16*)(a.ws + WS_P);
    bf16* VT = (bf16*)(a.ws + (which ? WS_VTW : WS_VTS));
    const int r = tid >> 3, c = tid & 7;
    const u32x4 v = *(const u32x4*)(P + (size_t)(b * T + 64 * tt + r) * NP + (which ? COL_VW : COL_VS) + hk * 64 + 8 * c);
    *(LAS u32x4*)(lds + r * 144 + c * 16) = v;
    __syncthreads();
    const int d = tid >> 3;
    unsigned short e[8];
#pragma unroll
    for (int j = 0; j < 8; ++j) e[j] = *(const LAS unsigned short*)(lds + (8 * c + j) * 144 + d * 2);
    u32x4 o; o.x = e[0] | ((unsigned)e[1] << 16); o.y = e[2] | ((unsigned)e[3] << 16); o.z = e[4] | ((unsigned)e[5] << 16); o.w = e[6] | ((unsigned)e[7] << 16);
    *(u32x4*)(VT + ((size_t)(b * 2 + hk) * 64 + d) * T + 64 * tt + 8 * c) = o;
    __syncthreads();
}

__device__ __forceinline__ void conv_row(const Args& a, int m, int lane) {
    const bf16* P = (const bf16*)(a.ws + WS_P); bf16* MIX = (bf16*)(a.ws + WS_MIX);
    const float* cw = a.in[9]; const float* gn = a.in[11];
    const int t = m & (T - 1), ch = 8 * lane;
    const bf16* row = P + (size_t)m * NP;
    float y[8];
#pragma unroll
    for (int e = 0; e < 8; ++e) y[e] = 0.f;
#pragma unroll
    for (int k = 0; k < 3; ++k) {
        const int dt = 2 - k;
        if (t - dt >= 0) {
            const u32x4 cv = *(const u32x4*)(row - (size_t)dt * NP + COL_CG + ch), uv = *(const u32x4*)(row - (size_t)dt * NP + COL_U + ch);
            const f32x4 w0 = *(const f32x4*)(cw + k * 512 + ch), w1 = *(const f32x4*)(cw + k * 512 + ch + 4);
            y[0] += w0.x * bf_lo(cv.x) * bf_lo(uv.x); y[1] += w0.y * bf_hi(cv.x) * bf_hi(uv.x);
            y[2] += w0.z * bf_lo(cv.y) * bf_lo(uv.y); y[3] += w0.w * bf_hi(cv.y) * bf_hi(uv.y);
            y[4] += w1.x * bf_lo(cv.z) * bf_lo(uv.z); y[5] += w1.y * bf_hi(cv.z) * bf_hi(uv.z);
            y[6] += w1.z * bf_lo(cv.w) * bf_lo(uv.w); y[7] += w1.w * bf_hi(cv.w) * bf_hi(uv.w);
        }
    }
    const u32x4 bv = *(const u32x4*)(row + COL_BG + ch);
    y[0] *= bf_lo(bv.x); y[1] *= bf_hi(bv.x); y[2] *= bf_lo(bv.y); y[3] *= bf_hi(bv.y); y[4] *= bf_lo(bv.z); y[5] *= bf_hi(bv.z); y[6] *= bf_lo(bv.w); y[7] *= bf_hi(bv.w);
    float s = 0.f;
#pragma unroll
    for (int e = 0; e < 8; ++e) s += y[e] * y[e];
    const float rs = 1.0f / sqrtf(wave_sum(s) * (1.f / 512.f) + EPS);
    const f32x4 g0 = *(const f32x4*)(gn + ch), g1 = *(const f32x4*)(gn + ch + 4);
    u32x4 o; o.x = pk2(y[0] * rs * g0.x, y[1] * rs * g0.y); o.y = pk2(y[2] * rs * g0.z, y[3] * rs * g0.w); o.z = pk2(y[4] * rs * g1.x, y[5] * rs * g1.y); o.w = pk2(y[6] * rs * g1.z, y[7] * rs * g1.w);
    *(u32x4*)(MIX + (size_t)m * D + 512 + ch) = o;
}

constexpr int AL_K0 = 0, AL_V0 = 18432, AL_IMP = 36864, AL_SELM = 54272, AL_WUN = 54784, AL_CTL = 54848;
constexpr int TPITCH = 144;
constexpr int IMPP = 68;

struct TileRegs { u32x4 k, v; };
__device__ __forceinline__ TileRegs tile_load(const bf16* kb, size_t kp, const bf16* vb, size_t vp, int tid) {
    const int r = tid >> 3, c = tid & 7; TileRegs t;
    t.k = *(const u32x4*)(kb + (size_t)r * kp + 8 * c); t.v = *(const u32x4*)(vb + (size_t)r * vp + 8 * c); return t;
}
__device__ __forceinline__ void tile_store(LAS unsigned char* lds, int buf, const TileRegs& t, int tid) {
    const int r = tid >> 3, c = tid & 7;
    *(LAS u32x4*)(lds + AL_K0 + buf * 9216 + r * TPITCH + c * 16) = t.k;
    *(LAS u32x4*)(lds + AL_V0 + buf * 9216 + r * TPITCH + c * 16) = t.v;
}

template <int MODE>
__device__ __forceinline__ void tile_compute(LAS unsigned char* lds, int buf, int pos0, int t, const bf16x8 (&Qf)[2][2], const float (&sl2)[2],
                                             float (&mrow)[2], float (&lrow)[2], f32x4 (&O)[2][4], bool selbit, LAS float* improw, int impj0, int lane) {
    const int r16 = lane & 15, kq = lane >> 4;
    const LAS unsigned char* Kb = lds + AL_K0 + buf * 9216; const LAS unsigned char* Vb = lds + AL_V0 + buf * 9216;
    f32x4 st[2][4];
#pragma unroll
    for (int qb = 0; qb < 2; ++qb)
#pragma unroll
        for (int kb = 0; kb < 4; ++kb) st[qb][kb] = (f32x4){0.f, 0.f, 0.f, 0.f};
#pragma unroll
    for (int kb = 0; kb < 4; ++kb)
#pragma unroll
        for (int ks = 0; ks < 2; ++ks) { const bf16x8 kf = *(const LAS bf16x8*)(Kb + (16 * kb + r16) * TPITCH + (32 * ks + 8 * kq) * 2);
#pragma unroll
            for (int qb = 0; qb < 2; ++qb) st[qb][kb] = __builtin_amdgcn_mfma_f32_16x16x32_bf16(kf, Qf[qb][ks], st[qb][kb], 0, 0, 0); }
    const float sc = 0.125f * LOG2E;
    float tmax[2] = {-1e30f, -1e30f};
    bool valid[4][4];
#pragma unroll
    for (int kb = 0; kb < 4; ++kb)
#pragma unroll
        for (int j = 0; j < 4; ++j) {
            const int kidx = 16 * kb + 4 * kq + j; int dist;
            if (MODE <= 1) dist = t - (16 * (pos0 + kidx) + 31); else dist = t - (pos0 + kidx);
            bool v = dist >= 0;
            if (MODE == 2) v = v && selbit;
            if (MODE == 3) v = v && (dist < 512);
            valid[kb][j] = v; const float fd = (float)dist;
#pragma unroll
            for (int qb = 0; qb < 2; ++qb) { float s = st[qb][kb][j] * sc - sl2[qb] * fd; s = v ? s : -1e30f; st[qb][kb][j] = s; tmax[qb] = fmaxf(tmax[qb], s); }
        }
    float mnew[2], alpha[2];
#pragma unroll
    for (int qb = 0; qb < 2; ++qb) {
        if (MODE == 1) { mnew[qb] = mrow[qb]; alpha[qb] = 1.f; }
        else { float tm = tmax[qb]; tm = fmaxf(tm, __shfl_xor(tm, 16)); tm = fmaxf(tm, __shfl_xor(tm, 32)); mnew[qb] = fmaxf(mrow[qb], tm); alpha[qb] = __builtin_amdgcn_exp2f(mrow[qb] - mnew[qb]); mrow[qb] = mnew[qb]; }
    }
#pragma unroll
    for (int qb = 0; qb < 2; ++qb) {
        float ps = 0.f;
#pragma unroll
        for (int kb = 0; kb < 4; ++kb)
#pragma unroll
            for (int j = 0; j < 4; ++j) { float p = valid[kb][j] ? __builtin_amdgcn_exp2f(st[qb][kb][j] - mnew[qb]) : 0.f; if (MODE == 1) p *= lrow[qb]; st[qb][kb][j] = p; ps += p; }
        if (MODE != 1) lrow[qb] = lrow[qb] * alpha[qb] + ps;
    }
    if (MODE == 0) return;
    if (MODE == 1) {
#pragma unroll
        for (int kb = 0; kb < 4; ++kb) {
            float vm = (st[0][kb][0] + st[0][kb][1]) + (st[0][kb][2] + 0.5f * st[0][kb][3]) + (st[1][kb][0] + st[1][kb][1]) + (st[1][kb][2] + 0.5f * st[1][kb][3]);
            float vh = 0.5f * st[0][kb][3] + 0.5f * st[1][kb][3];
            vm += __shfl_xor(vm, 8); vh += __shfl_xor(vh, 8);
            const int jj = impj0 + 4 * kb + kq;
            if ((lane & 8) == 0) { improw[jj] += vm; }
            if ((lane & 8) == 0) { improw[jj + 1] += vh; }
        }
    }
    if (MODE >= 2) {
#pragma unroll
        for (int qb = 0; qb < 2; ++qb)
#pragma unroll
            for (int db = 0; db < 4; ++db) O[qb][db] *= alpha[qb];
    }
    bf16x8 Pf[2][2];
#pragma unroll
    for (int qb = 0; qb < 2; ++qb)
#pragma unroll
        for (int s2 = 0; s2 < 2; ++s2) { u32x4 w; w.x = pk2(st[qb][2 * s2][0], st[qb][2 * s2][1]); w.y = pk2(st[qb][2 * s2][2], st[qb][2 * s2][3]);
            w.z = pk2(st[qb][2 * s2 + 1][0], st[qb][2 * s2 + 1][1]); w.w = pk2(st[qb][2 * s2 + 1][2], st[qb][2 * s2 + 1][3]); Pf[qb][s2] = __builtin_bit_cast(bf16x8, w); }
#pragma unroll
    for (int db = 0; db < 4; ++db)
#pragma unroll
        for (int s2 = 0; s2 < 2; ++s2) {
            const u32x2 lo = *(const LAS u32x2*)(Vb + (16 * db + r16) * TPITCH + (32 * s2 + 4 * kq) * 2);
            const u32x2 hi = *(const LAS u32x2*)(Vb + (16 * db + r16) * TPITCH + (32 * s2 + 16 + 4 * kq) * 2);
            u32x4 w; w.x = lo.x; w.y = lo.y; w.z = hi.x; w.w = hi.y; const bf16x8 vf = __builtin_bit_cast(bf16x8, w);
#pragma unroll
            for (int qb = 0; qb < 2; ++qb) O[qb][db] = __builtin_amdgcn_mfma_f32_16x16x32_bf16(vf, Pf[qb][s2], O[qb][db], 0, 0, 0);
        }
}

__device__ __forceinline__ void attn_item(const Args& a, LAS unsigned char* lds, int it, int tid) {
    const int lane = tid & 63, w = __builtin_amdgcn_readfirstlane(tid >> 6), r16 = lane & 15, kq = lane >> 4, tql = r16 & 7, gl = r16 >> 3;
    const int c = 63 - (it >> 4), b = (it >> 1) & 7, hk = it & 1;
    unsigned char* ws = a.ws;
    const bf16* P = (const bf16*)(ws + WS_P);
    const bf16* KC = (const bf16*)(ws + WS_KCMP) + (size_t)(b * 2 + hk) * 256 * 64;
    const bf16* VCT = (const bf16*)(ws + WS_VCMPT) + (size_t)(b * 2 + hk) * 64 * 256;
    const bf16* VTS = (const bf16*)(ws + WS_VTS) + (size_t)(b * 2 + hk) * 64 * T;
    const bf16* VTW = (const bf16*)(ws + WS_VTW) + (size_t)(b * 2 + hk) * 64 * T;
    const bf16* PKS = P + (size_t)b * T * NP + COL_KS + hk * 64;
    const bf16* PKW = P + (size_t)b * T * NP + COL_KW + hk * 64;
    const int tq = 8 * w + tql, t = 64 * c + tq; const size_t R = (size_t)b * T + t;
    LAS float* imp = (LAS float*)(lds + AL_IMP); LAS unsigned* selm = (LAS unsigned*)(lds + AL_SELM); LAS unsigned* wunl = (LAS unsigned*)(lds + AL_WUN);
    LAS float* improw = imp + tq * IMPP;

    bf16x8 Qf[2][2]; float sl2[2];
#pragma unroll
    for (int qb = 0; qb < 2; ++qb) { const int hq = hk * 4 + 2 * qb + gl; sl2[qb] = LOG2E * exp2f(-(float)(hq + 1));
#pragma unroll
        for (int ks = 0; ks < 2; ++ks) Qf[qb][ks] = *(const bf16x8*)(P + R * NP + COL_Q + hq * 64 + 32 * ks + 8 * kq); }
    float gate[2][3];
#pragma unroll
    for (int qb = 0; qb < 2; ++qb)
#pragma unroll
        for (int br = 0; br < 3; ++br) gate[qb][br] = sigmoidf_(bf1(P[R * NP + COL_G + hk * 12 + (2 * qb + gl) * 3 + br]));
    for (int i = lane; i < 8 * IMPP; i += 64) imp[(8 * w) * IMPP + i] = 0.f;

    f32x4 out[2][4], O[2][4];
#pragma unroll
    for (int qb = 0; qb < 2; ++qb)
#pragma unroll
        for (int db = 0; db < 4; ++db) { out[qb][db] = (f32x4){0.f, 0.f, 0.f, 0.f}; O[qb][db] = (f32x4){0.f, 0.f, 0.f, 0.f}; }
    float mrow[2] = {-1e30f, -1e30f}, lrow[2] = {0.f, 0.f};
    int buf = 0;
    TileRegs tr;

    const int nct = (4 * c + 3 + 63) >> 6;
    tr = tile_load(KC, 64, VCT, 256, tid);
    for (int ti = 0; ti < nct; ++ti) {
        tile_store(lds, buf, tr, tid); __syncthreads();
        { const int nx = (ti + 1 < nct) ? ti + 1 : 0; tr = tile_load(KC + (size_t)nx * 64 * 64, 64, VCT + nx * 64, 256, tid); }
        tile_compute<0>(lds, buf, 64 * ti, t, Qf, sl2, mrow, lrow, O, true, improw, 0, lane);
        buf ^= 1;
    }
#pragma unroll
    for (int qb = 0; qb < 2; ++qb) { float l = lrow[qb]; l += __shfl_xor(l, 16); l += __shfl_xor(l, 32); lrow[qb] = l > 0.f ? 1.0f / l : 0.f; }
    for (int ti = 0; ti < nct; ++ti) {
        tile_store(lds, buf, tr, tid); __syncthreads();
        if (ti + 1 < nct) tr = tile_load(KC + (size_t)(ti + 1) * 64 * 64, 64, VCT + (ti + 1) * 64, 256, tid);
        tile_compute<1>(lds, buf, 64 * ti, t, Qf, sl2, mrow, lrow, O, true, improw, 16 * ti, lane);
        buf ^= 1;
    }
#pragma unroll
    for (int qb = 0; qb < 2; ++qb)
#pragma unroll
        for (int db = 0; db < 4; ++db) { out[qb][db] = gate[qb][0] * O[qb][db]; O[qb][db] = (f32x4){0.f, 0.f, 0.f, 0.f}; }

    unsigned long long wun = 0ull;
    for (int tt = 0; tt < 8; ++tt) {
        LAS float* row = imp + (8 * w + tt) * IMPP;
        float mine = row[lane];
        if (lane == 0 || lane == c || lane == c - 1) mine = 1e30f;
        if (lane > c) mine = -1e30f;
        row[lane] = mine;
        int rank = 0;
#pragma unroll
        for (int i4 = 0; i4 < 16; ++i4) { const f32x4 v = *(const LAS f32x4*)(row + 4 * i4);
#pragma unroll
            for (int e = 0; e < 4; ++e) { const int i = 4 * i4 + e; rank += ((v[e] > mine) || (v[e] == mine && i < lane)) ? 1 : 0; } }
        const bool sel = (rank < 16) && (lane <= c);
        const unsigned long long mk = __ballot(sel);
        wun |= mk;
        if (lane == 0) { selm[(8 * w + tt) * 2] = (unsigned)mk; selm[(8 * w + tt) * 2 + 1] = (unsigned)(mk >> 32); }
    }
    if (lane == 0) { wunl[2 * w] = (unsigned)wun; wunl[2 * w + 1] = (unsigned)(wun >> 32); }
    const unsigned long long mysel = (unsigned long long)selm[tq * 2] | ((unsigned long long)selm[tq * 2 + 1] << 32);
    __syncthreads();
    unsigned long long uni = 0ull;
#pragma unroll
    for (int i = 0; i < 8; ++i) uni |= (unsigned long long)wunl[2 * i] | ((unsigned long long)wunl[2 * i + 1] << 32);
    uni = ((unsigned long long)__builtin_amdgcn_readfirstlane((unsigned)(uni >> 32)) << 32) | (unsigned long long)__builtin_amdgcn_readfirstlane((unsigned)uni);

    mrow[0] = mrow[1] = -1e30f; lrow[0] = lrow[1] = 0.f;
    {
        int j = __builtin_ctzll(uni);
        tr = tile_load(PKS + (size_t)(64 * j) * NP, NP, VTS + 64 * j, T, tid);
        while (uni) {
            j = __builtin_ctzll(uni); uni &= uni - 1;
            tile_store(lds, buf, tr, tid); __syncthreads();
            if (uni) { const int jn = __builtin_ctzll(uni); tr = tile_load(PKS + (size_t)(64 * jn) * NP, NP, VTS + 64 * jn, T, tid); }
            if ((wun >> j) & 1ull) tile_compute<2>(lds, buf, 64 * j, t, Qf, sl2, mrow, lrow, O, ((mysel >> j) & 1ull) != 0ull, improw, 0, lane);
            buf ^= 1;
        }
    }
#pragma unroll
    for (int qb = 0; qb < 2; ++qb) { float l = lrow[qb]; l += __shfl_xor(l, 16); l += __shfl_xor(l, 32); const float inv = (l > 0.f ? 1.0f / l : 0.f) * gate[qb][1];
#pragma unroll
        for (int db = 0; db < 4; ++db) { out[qb][db] += inv * O[qb][db]; O[qb][db] = (f32x4){0.f, 0.f, 0.f, 0.f}; } }

    mrow[0] = mrow[1] = -1e30f; lrow[0] = lrow[1] = 0.f;
    {
        const int j0 = c >= 8 ? c - 8 : 0;
        tr = tile_load(PKW + (size_t)(64 * j0) * NP, NP, VTW + 64 * j0, T, tid);
        for (int j = j0; j <= c; ++j) {
            tile_store(lds, buf, tr, tid); __syncthreads();
            if (j < c) tr = tile_load(PKW + (size_t)(64 * (j + 1)) * NP, NP, VTW + 64 * (j + 1), T, tid);
            tile_compute<3>(lds, buf, 64 * j, t, Qf, sl2, mrow, lrow, O, true, improw, 0, lane);
            buf ^= 1;
        }
    }
    float ss = 0.f;
    bf16* OA = (bf16*)(ws + WS_OATT);
#pragma unroll
    for (int qb = 0; qb < 2; ++qb) { float l = lrow[qb]; l += __shfl_xor(l, 16); l += __shfl_xor(l, 32); const float inv = (l > 0.f ? 1.0f / l : 0.f) * gate[qb][2];
#pragma unroll
        for (int db = 0; db < 4; ++db) { const f32x4 o = out[qb][db] + inv * O[qb][db]; ss += (o.x * o.x + o.y * o.y) + (o.z * o.z + o.w * o.w);
            u32x2 pk; pk.x = pk2(o.x, o.y); pk.y = pk2(o.z, o.w);
            *(u32x2*)(OA + R * 512 + hk * 256 + (2 * qb + gl) * 64 + 16 * db + 4 * kq) = pk; } }
    ss += __shfl_xor(ss, 8); ss += __shfl_xor(ss, 16); ss += __shfl_xor(ss, 32);
    if (lane < 8) ((float*)(ws + WS_SSA))[R * 2 + hk] = ss;
    __syncthreads();
}


#define RLX_AGENT __ATOMIC_RELAXED, __HIP_MEMORY_SCOPE_AGENT
#define XB_TMO      128
#define XB_XCNT(j)  (256  + 64 * (j))
#define XB_XSUB(j)  (1280 + 64 * (j))
#define XB_XGEN(j)  (2304 + 64 * (j))
#define XB_TOP      3328
#define XB_TOPGEN   3392
#define XCD_BAR_WORDS 3456
#define XB_SPIN_CAP (1u << 18)

__device__ __forceinline__ unsigned xb_ld(unsigned* p)              { return __hip_atomic_load(p, __ATOMIC_RELAXED, __HIP_MEMORY_SCOPE_AGENT); }
__device__ __forceinline__ unsigned xb_add(unsigned* p, unsigned v) { return __hip_atomic_fetch_add(p, v, __ATOMIC_RELAXED, __HIP_MEMORY_SCOPE_AGENT); }
__device__ __forceinline__ unsigned xb_xcc_id() { return (unsigned)__builtin_amdgcn_s_getreg((3 << 11) | 20) & 0xFu; }
#define XB_SPIN(cond, bar) do { unsigned _sp = 0; while (cond) { __builtin_amdgcn_s_sleep(1); \
    if ((++_sp & 255u) == 0u) { if (xb_ld(&(bar)[XB_TMO])) break; if (_sp > XB_SPIN_CAP) { atomicAdd(&(bar)[XB_TMO], 1u); break; } } } } while (0)

struct XcdBarrier {
    unsigned* bar; unsigned x;
    volatile LAS unsigned* st;
};

__device__ __forceinline__ XcdBarrier xcd_barrier_post(unsigned* bar, volatile LAS unsigned* st) {
    XcdBarrier b; b.bar = bar; b.x = xb_xcc_id(); b.st = st;
    if (threadIdx.x == 0) (void)xb_add(&bar[XB_XCNT(b.x)], 1u);
    return b;
}
__device__ __forceinline__ void xcd_barrier_complete(unsigned* bar, unsigned x, unsigned& nloc, unsigned& nx) {
    const unsigned G = gridDim.x * gridDim.y * gridDim.z;
    unsigned sum, cnt, mine, sp = 0u;
    for (;;) {
        sum = 0u; cnt = 0u; mine = 0u;
#pragma unroll
        for (unsigned j = 0; j < 16; ++j) { const unsigned c = xb_ld(&bar[XB_XCNT(j)]); sum += c; cnt += (c > 0u) ? 1u : 0u; mine = (j == x) ? c : mine; }
        if (sum == G) break;
        __builtin_amdgcn_s_sleep(1);
        if ((++sp & 255u) == 0u) { if (xb_ld(&bar[XB_TMO])) break; if (sp > XB_SPIN_CAP) { atomicAdd(&bar[XB_TMO], 1u); break; } }
    }
    nloc = mine > 0u ? mine : 1u; nx = cnt > 0u ? cnt : 1u;
}

__device__ __forceinline__ void xcd_barrier(const XcdBarrier& b) {
    asm volatile("s_waitcnt vmcnt(0)" ::: "memory");
    __syncthreads();
    if (threadIdx.x == 0) {
        unsigned* bar = b.bar;
        __builtin_amdgcn_s_waitcnt(0);
        unsigned nloc = b.st[0], nx = b.st[1];
        if (nloc == 0u) { xcd_barrier_complete(bar, b.x, nloc, nx); b.st[0] = nloc; b.st[1] = nx; }
        const unsigned old = xb_add(&bar[XB_XSUB(b.x)], 1u);
        const unsigned gen = old / nloc;
        if (old + 1u == (gen + 1u) * nloc) {
            __builtin_amdgcn_fence(__ATOMIC_RELEASE, "agent");
            asm volatile("s_waitcnt vmcnt(0)" ::: "memory");
            const unsigned og = xb_add(&bar[XB_TOP], 1u);
            const unsigned tg = og / nx;
            if (og + 1u == (tg + 1u) * nx) xb_add(&bar[XB_TOPGEN], 1u);
            else XB_SPIN(xb_ld(&bar[XB_TOPGEN]) == tg, bar);
            __builtin_amdgcn_fence(__ATOMIC_ACQUIRE, "agent");
            xb_add(&bar[XB_XGEN(b.x)], 1u);
            asm volatile("s_waitcnt vmcnt(0)" ::: "memory");
        } else {
            XB_SPIN(xb_ld(&bar[XB_XGEN(b.x)]) == gen, bar);
            __builtin_amdgcn_fence(__ATOMIC_ACQUIRE, "agent");
            asm volatile("s_waitcnt vmcnt(0)" ::: "memory");
        }
    }
    __syncthreads();
}

constexpr int NPHASE = 11;
__global__ void __launch_bounds__(NWAVES * 64, 2) hymba_fwd(Args args) {
    extern __shared__ __attribute__((aligned(16))) unsigned char lds_raw[];
    LAS unsigned char* lds = (LAS unsigned char*)lds_raw;
    cg::grid_group grid = cg::this_grid();
    const int tid = threadIdx.x, lane = tid & 63, wave = __builtin_amdgcn_readfirstlane(tid >> 6);
    const int G = gridDim.x, bx = blockIdx.x;
    const int gw = bx * NWAVES + wave, NGW = G * NWAVES;
    unsigned char* ws = args.ws;
    const int lo = args.ph_lo, hi = args.ph_hi;
#define IN(k) (lo <= (k) && (k) < hi)
    if (tid < 16) ((LAS unsigned*)(lds + BARLDS_OFF))[tid] = 0u;
    __syncthreads();
    XcdBarrier bar = xcd_barrier_post((unsigned*)(ws + WS_CTL) + CW_BAR, (volatile LAS unsigned*)(lds + BARLDS_OFF));
#define SEAM(k) do { if (IN(k) && IN((k) + 1)) { if ((k) == 0) grid.sync(); else xcd_barrier(bar); } } while (0)

    if (IN(0)) {
        LAS float* scr = (LAS float*)(lds + wave * 16384);
        constexpr int I_IN = 16 * 96, I_OUT = 16 * 32, I_G = 16 * 88, I_DN = 44 * 32, I_C1 = 32 * 4;
        constexpr int NITEMS = I_IN + I_OUT + 2 * I_G + I_DN + 2 * I_C1;
        for (int it = gw; it < NITEMS; it += NGW) {
            int r = it;
            if (r < I_IN) { p0_transpose_item(args.in[2], D, NPROJ, (bf16*)(ws + WS_WIN), 0, scr, r, 96, lane); continue; } r -= I_IN;
            if (r < I_OUT) { p0_transpose_item(args.in[12], D, D, (bf16*)(ws + WS_WOUT), 0, scr, r, 32, lane); continue; } r -= I_OUT;
            if (r < I_G) { const int n0 = 32 * (r % 88); p0_transpose_item(args.in[14], D, DFF, (bf16*)(ws + WS_WGU), 256 * (n0 >> 7) + (n0 & 127) - n0, scr, r, 88, lane); continue; } r -= I_G;
            if (r < I_G) { const int n0 = 32 * (r % 88); p0_transpose_item(args.in[15], D, DFF, (bf16*)(ws + WS_WGU), 256 * (n0 >> 7) + 128 + (n0 & 127) - n0, scr, r, 88, lane); continue; } r -= I_G;
            if (r < I_DN) { p0_transpose_item(args.in[18], DFF, D, (bf16*)(ws + WS_WDN), 0, scr, r, 32, lane); continue; } r -= I_DN;
            if (r < I_C1) { p0_transpose_item(args.in[4], 2048, 128, (bf16*)(ws + WS_WC1K), 0, scr, r, 4, lane); continue; } r -= I_C1;
            p0_transpose_item(args.in[7], 2048, 128, (bf16*)(ws + WS_WC1V), 0, scr, r, 4, lane);
        }
        for (int m = gw; m < M; m += NGW) rms_row_bf16(args.in[0] + (size_t)m * D, args.in[1], (bf16*)(ws + WS_XN) + (size_t)m * D, lane);
    }
    SEAM(0);
    if (IN(1)) {
        pg8::Gemm g{(const pg8::bf16_t*)(ws + WS_XN), (const pg8::bf16_t*)(ws + WS_WIN), M, NP, D}; pg8::StaticOrder S; S.init(M, NP, G, bx);
        pg8::EpiBf16 E{(pg8::bf16_t*)(ws + WS_P), NP, 0, 0};
        pg8::gemm_phase<pg8::EpiBf16, pg8::StaticOrder, true, true>(lds, g, S, E);
    }
    SEAM(1);
    if (IN(2)) {
        for (int it = bx; it < 256; it += G) compress_item(args, lds, it, tid);
        for (int it = bx; it < 2048; it += G) vtrans_item(args, lds, it, tid);
        for (int m = gw; m < M; m += NGW) conv_row(args, m, lane);
    }
    SEAM(2);
    if (IN(3)) {
        LAS int* ctl = (LAS int*)(lds + AL_CTL);
        for (;;) {
            if (tid == 0) ctl[0] = (int)atomicAdd((unsigned*)(ws + WS_CTL), 1u);
            __syncthreads();
            const int it = ctl[0];
            if (it >= 1024) break;
            attn_item(args, lds, it, tid);
        }
    }
    SEAM(3);
    if (IN(4)) {
        const bf16* OA = (const bf16*)(ws + WS_OATT); const float* ssa = (const float*)(ws + WS_SSA); bf16* MIX = (bf16*)(ws + WS_MIX); const float* gn = args.in[10];
        for (int m = gw; m < M; m += NGW) {
            const float rs = 1.0f / sqrtf((ssa[2 * m] + ssa[2 * m + 1]) * (1.f / 512.f) + EPS);
            const int ch = 8 * lane; const u32x4 v = *(const u32x4*)(OA + (size_t)m * 512 + ch);
            const f32x4 g0 = *(const f32x4*)(gn + ch), g1 = *(const f32x4*)(gn + ch + 4);
            u32x4 o; o.x = pk2(bf_lo(v.x) * rs * g0.x, bf_hi(v.x) * rs * g0.y); o.y = pk2(bf_lo(v.y) * rs * g0.z, bf_hi(v.y) * rs * g0.w);
            o.z = pk2(bf_lo(v.z) * rs * g1.x, bf_hi(v.z) * rs * g1.y); o.w = pk2(bf_lo(v.w) * rs * g1.z, bf_hi(v.w) * rs * g1.w);
            *(u32x4*)(MIX + (size_t)m * D + ch) = o;
        }
    }
    SEAM(4);
    if (IN(5)) {
        pg8::Gemm g{(const pg8::bf16_t*)(ws + WS_MIX), (const pg8::bf16_t*)(ws + WS_WOUT), M, D, D}; pg8::StaticOrder S; S.init(M, D, G, bx);
        pg8::EpiResF32 E{args.in[0], args.out, D};
        pg8::gemm_phase<pg8::EpiResF32, pg8::StaticOrder, true, true>(lds, g, S, E);
    }
    SEAM(5);
    if (IN(6)) {
        for (int m = gw; m < M; m += NGW) rms_row_bf16(args.out + (size_t)m * D, args.in[13], (bf16*)(ws + WS_XN) + (size_t)m * D, lane);
    }
    SEAM(6);
    if (IN(7)) {
        constexpr int NMT = (M + 251) / 252;
        pg8::Gemm g{(const pg8::bf16_t*)(ws + WS_XN), (const pg8::bf16_t*)(ws + WS_WGU), NMT * 256, NGU, D}; pg8::StaticOrder S; S.init(NMT * 256, NGU, G, bx);
        pg8::EpiFfn E{(pg8::bf16_t*)(ws + WS_ACT), args.in[16], args.in[17], M, DFF, T};
        pg8::gemm_phase<pg8::EpiFfn, pg8::StaticOrder, true, true, true>(lds, g, S, E);
    }
    SEAM(7);
    if (IN(9)) {
        pg8::Gemm g{(const pg8::bf16_t*)(ws + WS_ACT), (const pg8::bf16_t*)(ws + WS_WDN), M, D, DFF}; pg8::StaticOrder S; S.init(M, D, G, bx);
        pg8::EpiResF32 E{args.out, args.out, D};
        pg8::gemm_phase<pg8::EpiResF32, pg8::StaticOrder, true, true>(lds, g, S, E);
    }
    SEAM(9);
    if (IN(10)) {
        const float* gn = args.in[19];
        for (int m = gw; m < M; m += NGW) {
            f32x4* xr = (f32x4*)(args.out + (size_t)m * D) + lane; const f32x4* gr = (const f32x4*)gn + lane;
            f32x4 v[4]; float s = 0.f;
#pragma unroll
            for (int j = 0; j < 4; ++j) { v[j] = xr[64 * j]; s += (v[j].x * v[j].x + v[j].y * v[j].y) + (v[j].z * v[j].z + v[j].w * v[j].w); }
            const float rs = 1.0f / sqrtf(wave_sum(s) * (1.f / D) + EPS);
#pragma unroll
            for (int j = 0; j < 4; ++j) xr[64 * j] = v[j] * rs * gr[64 * j];
        }
    }
#undef IN
#undef SEAM
}

extern "C" void kernel_launch(void* const* d_in, const int* in_sizes, int n_in, void* d_out, int out_size, void* d_ws, size_t ws_size, hipStream_t stream) {
    static int grid = 0;
    if (grid == 0) {
        if (n_in != 20 || in_sizes[0] != M * D || out_size != M * D || ws_size < WS_END) { fprintf(stderr, "kernel_launch: unexpected sizes n_in %d in0 %d out %d ws %zu\n", n_in, n_in > 0 ? in_sizes[0] : -1, out_size, ws_size); grid = -1; return; }
        int dev = 0, cus = 0, per_cu = 0;
        hipGetDevice(&dev); hipDeviceGetAttribute(&cus, hipDeviceAttributeMultiprocessorCount, dev);
        if (hipFuncSetAttribute((const void*)hymba_fwd, hipFuncAttributeMaxDynamicSharedMemorySize, LDS_BYTES) != hipSuccess) { fprintf(stderr, "kernel_launch: hipFuncSetAttribute failed\n"); grid = -1; return; }
        if (hipOccupancyMaxActiveBlocksPerMultiprocessor(&per_cu, (const void*)hymba_fwd, NWAVES * 64, LDS_BYTES) != hipSuccess || per_cu < 1) { fprintf(stderr, "kernel_launch: occupancy query says %d\n", per_cu); per_cu = 1; }
        (void)hipGetLastError();
        grid = cus * per_cu;
    }
    if (grid < 0) return;
    if (hipMemsetAsync((char*)d_ws + WS_CTL, 0, CTL_ZERO_BYTES, stream) != hipSuccess) { fprintf(stderr, "kernel_launch: memset failed\n"); return; }
    Args a{};
    for (int i = 0; i < 20; ++i) a.in[i] = (const float*)d_in[i];
    a.out = (float*)d_out; a.ws = (unsigned char*)d_ws;
#if MK_N_LAUNCHES == 1
    a.ph_lo = 0; a.ph_hi = NPHASE;
    void* kargs[] = {&a};
    hipError_t e = hipLaunchCooperativeKernel((const void*)hymba_fwd, dim3(grid), dim3(NWAVES * 64), kargs, LDS_BYTES, stream);
    if (e != hipSuccess) fprintf(stderr, "cooperative launch failed: %s (grid %d)\n", hipGetErrorString(e), grid);
#else
    for (int p = 0; p < NPHASE; ++p) { a.ph_lo = p; a.ph_hi = p + 1; hipLaunchKernelGGL(hymba_fwd, dim3(grid), dim3(NWAVES * 64), LDS_BYTES, stream, a); }
#endif
}
```

```cpp
#include <hip/hip_runtime.h>
#include <hip/hip_cooperative_groups.h>
#include <cstdio>
#include <cstdint>
namespace cg = cooperative_groups;
namespace pg8 {
#define PG8_LAS __attribute__((address_space(3)))
typedef unsigned short bf16_t;
typedef short bf16x8 __attribute__((ext_vector_type(8)));
typedef float f32x4 __attribute__((ext_vector_type(4)));
typedef unsigned u32x4 __attribute__((ext_vector_type(4)));
constexpr int BM = 256, BK = 64, HALF = 128, HTB = HALF * BK * 2  , STAGE_BYTES = 8 * HTB, NXCD = 8, WGM = 8;

__host__ __device__ __forceinline__ int lds_byte(int r, int c) { const int st = (r >> 4) * 2 + (c >> 5), rr = r & 15, cc = c & 31, ob = rr * 64 + cc * 2; return st * 1024 + (ob ^ (((ob >> 9) & 1) << 5)); }
__host__ __device__ __forceinline__ void stage_rc(int b, int& R, int& C) { const int st = b / 1024, sb = b % 1024, swz = sb ^ (((sb >> 9) & 1) << 5); R = (st >> 1) * 16 + swz / 64; C = (st & 1) * 32 + (swz % 64) / 2; }
__host__ __device__ __forceinline__ int perm32(int rho) { const int n = rho >> 4, i = rho & 15; return 8 * (i >> 2) + 4 * n + (i & 3); }

struct Unit { int pm, pn; };
struct Gemm { const bf16_t* A; const bf16_t* Bt; int M, N, K; };

struct StaticOrder {
    int nM, nN, nwg, G, c;
    __host__ __device__ void init(int M, int N, int G_, int c_) { nM = M / BM; nN = N / BM; nwg = nM * nN; G = G_; c = c_; }
    __host__ __device__ bool next(int i, Unit& u) const {
        const long L = (long)i * G + c; if (L >= nwg) return false;
        int wgid = (int)L; { const int q = nwg / NXCD, r = nwg % NXCD, xcd = wgid % NXCD, off = wgid / NXCD; wgid = (xcd < r ? xcd * (q + 1) : r * (q + 1) + (xcd - r) * q) + off; }
        const int nig = WGM * nN, gid = wgid / nig, fm = gid * WGM, gsz = (nM - fm) < WGM ? (nM - fm) : WGM;
        u.pm = fm + ((wgid % nig) % gsz); u.pn = (wgid % nig) / gsz; return true;
    }
    __device__ __forceinline__ void a_ready(const Unit&) const {}
    __device__ __forceinline__ void done(const Unit&) const {}
};

__device__ __forceinline__ unsigned cvt_pk_bf16(float lo, float hi) { unsigned r; asm volatile("v_cvt_pk_bf16_f32 %0, %1, %2" : "=v"(r) : "v"(lo), "v"(hi)); return r; }

struct EpiBf16 {
    static constexpr bool PERM = true, AFTER_DRAIN = false;
    bf16_t* O; int ldc; int split_cols; size_t split_stride;
    __device__ __forceinline__ void operator()(const f32x4 (&acc)[2][2][4][2], const Unit& u, int wr, int wc, int fr, int fq) const {
        const int row0 = u.pm * BM + wr * 64 + fr; int colt = u.pn * BM; bf16_t* base = O;
        if (split_cols) { const int t = colt / split_cols; base += (size_t)t * split_stride; colt -= t * split_cols; }
        const int col0 = colt + wc * 32 + 8 * fq;
#pragma unroll
        for (int ai = 0; ai < 2; ++ai)
#pragma unroll
            for (int m = 0; m < 4; ++m) { bf16_t* rowp = base + (size_t)(row0 + ai * HALF + m * 16) * ldc + col0;
#pragma unroll
                for (int bj = 0; bj < 2; ++bj) { const f32x4 v0 = acc[ai][bj][m][0], v1 = acc[ai][bj][m][1];
                    u32x4 w; w.x = cvt_pk_bf16(v0[0], v0[1]); w.y = cvt_pk_bf16(v0[2], v0[3]); w.z = cvt_pk_bf16(v1[0], v1[1]); w.w = cvt_pk_bf16(v1[2], v1[3]);
                    *(u32x4*)(rowp + bj * HALF) = w; } }
    }
};
struct EpiResF32 {
    static constexpr bool PERM = false, AFTER_DRAIN = false;
    const float* base; float* out; int ldc;
    __device__ __forceinline__ void operator()(const f32x4 (&acc)[2][2][4][2], const Unit& u, int wr, int wc, int fr, int fq) const {
        const int col0 = u.pn * BM + wc * 32 + 4 * fq;
#pragma unroll
        for (int ai = 0; ai < 2; ++ai)
#pragma unroll
            for (int m = 0; m < 4; ++m) { const size_t off = (size_t)(u.pm * BM + ai * HALF + wr * 64 + m * 16 + fr) * ldc + col0;
#pragma unroll
                for (int bj = 0; bj < 2; ++bj)
#pragma unroll
                    for (int n = 0; n < 2; ++n) { const f32x4 bs = *(const f32x4*)(base + off + bj * HALF + n * 16); *(f32x4*)(out + off + bj * HALF + n * 16) = bs + acc[ai][bj][m][n]; } }
    }
};


struct EpiFfn {
    static constexpr bool PERM = true, AFTER_DRAIN = false;
    bf16_t* ACT; const float* cw; const float* cb; int Mrows; int DFFc; int Tseq;
    __device__ __forceinline__ void operator()(const f32x4 (&acc)[2][2][4][2], const Unit& u, int wr, int wc, int fr, int fq) const {
        const int ch0 = u.pn * 128 + wc * 32 + 8 * fq;
        const int rbase = 252 * u.pm - 2 + 126 * wr + 8 * fr;
        f32x4 w0[2], w1[2], w2[2], bb[2];
#pragma unroll
        for (int n = 0; n < 2; ++n) { w0[n] = *(const f32x4*)(cw + ch0 + 4 * n); w1[n] = *(const f32x4*)(cw + DFFc + ch0 + 4 * n); w2[n] = *(const f32x4*)(cw + 2 * DFFc + ch0 + 4 * n); bb[n] = *(const f32x4*)(cb + ch0 + 4 * n); }
        float p6[2][4], p7[2][4];
#pragma unroll
        for (int n = 0; n < 2; ++n)
#pragma unroll
            for (int i = 0; i < 4; ++i) { p7[n][i] = __shfl_up(acc[1][0][3][n][i], 1, 16); p6[n][i] = __shfl_up(acc[1][0][2][n][i], 1, 16); }
#pragma unroll
        for (int k = 0; k < 8; ++k) {
            const int r = rbase + k, tk = r & (Tseq - 1);
            const bool ok = (8 * fr + k >= 2) && (r < Mrows);
            float o[2][4];
#pragma unroll
            for (int n = 0; n < 2; ++n)
#pragma unroll
                for (int i = 0; i < 4; ++i) {
                    const float gk = acc[k >> 2][0][k & 3][n][i];
                    float gm1 = (k >= 1) ? acc[(k >= 1 ? k - 1 : 0) >> 2][0][(k >= 1 ? k - 1 : 0) & 3][n][i] : p7[n][i];
                    float gm2 = (k >= 2) ? acc[(k >= 2 ? k - 2 : 0) >> 2][0][(k >= 2 ? k - 2 : 0) & 3][n][i] : (k == 1 ? p7[n][i] : p6[n][i]);
                    gm1 = tk >= 1 ? gm1 : 0.f; gm2 = tk >= 2 ? gm2 : 0.f;
                    const float gt = w0[n][i] * gm2 + w1[n][i] * gm1 + w2[n][i] * gk + bb[n][i];
                    o[n][i] = gt * (1.0f / (1.0f + __expf(-gt))) * acc[k >> 2][1][k & 3][n][i];
                }
            u32x4 w; w.x = cvt_pk_bf16(o[0][0], o[0][1]); w.y = cvt_pk_bf16(o[0][2], o[0][3]); w.z = cvt_pk_bf16(o[1][0], o[1][1]); w.w = cvt_pk_bf16(o[1][2], o[1][3]);
            if (ok) *(u32x4*)(ACT + (size_t)r * DFFc + ch0) = w;
        }
    }
};

template <class Epi, class Sched, bool ALIGN_EPI = false, bool SP2 = false, bool AMAP = false>
__device__ __forceinline__ void gemm_phase(PG8_LAS unsigned char* lds, const Gemm g, const Sched& S, const Epi& E) {
    const int tid = threadIdx.x, wid = __builtin_amdgcn_readfirstlane(tid >> 6), lane = tid & 63, wr = wid >> 2, wc = wid & 3, fr = lane & 15, fq = lane >> 4;
    const int K = g.K, nt = K / BK;
    unsigned voffA[2], voffB[2];
#pragma unroll
    for (int i = 0; i < 2; ++i) { int R, C; stage_rc(tid * 16 + i * 8192, R, C); const int Rb = Epi::PERM ? ((R & ~31) + perm32(R & 31)) : R;
        const int Ra = AMAP ? (126 * (R >> 6) + 8 * (R & 15) + ((R >> 4) & 3)) : R; voffA[i] = (unsigned)(Ra * K + C) * 2u; voffB[i] = (unsigned)(Rb * K + C) * 2u; }
    const size_t kstep = (size_t)(BK * 2);
    const size_t hstep = (size_t)HALF * K * 2;
    const size_t tstep = 2 * hstep;
    const size_t hstepA = AMAP ? (size_t)4 * K * 2 : hstep;
#define PG8_AOFF(pm) (AMAP ? ((ptrdiff_t)252 * (pm) - 2) * (ptrdiff_t)K * 2 : (ptrdiff_t)((size_t)(pm) * tstep))
    const unsigned ldsw = (unsigned)wid * 1024u;
    const int aoff = lds_byte(wr * 64 + fr, fq * 8), boff = lds_byte(wc * 32 + fr, fq * 8);
#define PG8_SA(b, h) (((b) * 2 + (h)) * HTB)
#define PG8_SB(b, h) ((4 + (b) * 2 + (h)) * HTB)
#define PG8_STAGE(bufoff, gbase, voff) do { _Pragma("unroll") for (int _i = 0; _i < 2; ++_i) \
        __builtin_amdgcn_global_load_lds((const unsigned*)((const char*)(gbase) + (voff)[_i]), (PG8_LAS unsigned*)(lds + (bufoff) + ldsw + _i * 8192), 16, 0, 0); } while (0)
#define PG8_LDA(dst, b, h) do { _Pragma("unroll") for (int m = 0; m < 4; ++m) _Pragma("unroll") for (int k = 0; k < 2; ++k) dst[m][k] = *(const PG8_LAS bf16x8*)(lds + PG8_SA(b, h) + aoff + m * 2048 + k * 1024); } while (0)
#define PG8_LDB(dst, b, h) do { _Pragma("unroll") for (int n = 0; n < 2; ++n) _Pragma("unroll") for (int k = 0; k < 2; ++k) dst[n][k] = *(const PG8_LAS bf16x8*)(lds + PG8_SB(b, h) + boff + n * 2048 + k * 1024); } while (0)
#define PG8_MMA(ai, bj, At, Bt) do { __builtin_amdgcn_s_setprio(1); _Pragma("unroll") for (int m = 0; m < 4; ++m) _Pragma("unroll") for (int n = 0; n < 2; ++n) _Pragma("unroll") for (int k = 0; k < 2; ++k) \
        acc[ai][bj][m][n] = __builtin_amdgcn_mfma_f32_16x16x32_bf16(Bt[n][k], At[m][k], acc[ai][bj][m][n], 0, 0, 0); __builtin_amdgcn_s_setprio(0); } while (0)
#define PG8_WAIT_V(n) asm volatile("s_waitcnt vmcnt(" #n ")" ::: "memory")
#define PG8_WAIT_L(n) asm volatile("s_waitcnt lgkmcnt(" #n ")" ::: "memory")
#define PG8_BAR __builtin_amdgcn_s_barrier()
#define PG8_SCHED __builtin_amdgcn_sched_barrier(0)
    Unit cur, nxt; int ui = 0;
    if (!S.next(0, cur)) return;
    f32x4 acc[2][2][4][2];
#pragma unroll
    for (int a = 0; a < 2; ++a)
#pragma unroll
        for (int b = 0; b < 2; ++b)
#pragma unroll
            for (int m = 0; m < 4; ++m)
#pragma unroll
                for (int n = 0; n < 2; ++n) acc[a][b][m][n] = (f32x4){0.f, 0.f, 0.f, 0.f};
    bf16x8 At[4][2], B0[2][2], B1[2][2];
    const char* cA = (const char*)g.A + PG8_AOFF(cur.pm); const char* cB = (const char*)g.Bt + (size_t)cur.pn * tstep;
    S.a_ready(cur);
    if constexpr (SP2) {
        PG8_STAGE(PG8_SB(0, 0), cB, voffB); PG8_STAGE(PG8_SB(0, 1), cB + hstep, voffB); PG8_STAGE(PG8_SA(0, 0), cA, voffA); PG8_STAGE(PG8_SA(0, 1), cA + hstepA, voffA);
        if (wr == 1) PG8_BAR;
        PG8_WAIT_V(2); PG8_BAR;
        PG8_STAGE(PG8_SB(1, 0), cB + kstep, voffB); PG8_STAGE(PG8_SA(1, 0), cA + kstep, voffA); PG8_STAGE(PG8_SB(1, 1), cB + hstep + kstep, voffB);
        PG8_WAIT_V(6); PG8_BAR;
    } else {
        PG8_STAGE(PG8_SB(0, 0), cB, voffB); PG8_STAGE(PG8_SA(0, 0), cA, voffA); PG8_STAGE(PG8_SB(0, 1), cB + hstep, voffB); PG8_STAGE(PG8_SA(0, 1), cA + hstepA, voffA);
        if (wr == 1) PG8_BAR;
        PG8_WAIT_V(4); PG8_BAR;
        PG8_STAGE(PG8_SB(1, 0), cB + kstep, voffB); PG8_STAGE(PG8_SA(1, 0), cA + kstep, voffA); PG8_STAGE(PG8_SB(1, 1), cB + hstep + kstep, voffB);
        PG8_WAIT_V(6); PG8_BAR;
    }
    for (;;) {
        const bool has_next = S.next(ui + 1, nxt);
        const char* nA = has_next ? (const char*)g.A + PG8_AOFF(nxt.pm) : cA; const char* nB = has_next ? (const char*)g.Bt + (size_t)nxt.pn * tstep : cB;
        for (int t = 0; t < nt; t += 2) {
            const bool last = (t == nt - 2);
            const char* a1 = cA + (size_t)(t + 1) * kstep;
            const char* a2 = last ? nA : cA + (size_t)(t + 2) * kstep; const char* b2 = last ? nB : cB + (size_t)(t + 2) * kstep;
            const char* a3 = a2 + kstep; const char* b3 = b2 + kstep;
            if (last && has_next) S.a_ready(nxt);
            if constexpr (SP2) {
            PG8_LDB(B0, 0, 0); PG8_LDB(B1, 0, 1); PG8_SCHED; PG8_LDA(At, 0, 0); PG8_STAGE(PG8_SA(1, 1), a1 + hstepA, voffA);
            PG8_WAIT_V(8); PG8_WAIT_L(0); PG8_BAR; PG8_MMA(0, 0, At, B0); PG8_MMA(0, 1, At, B1); PG8_BAR; PG8_SCHED;
            PG8_LDA(At, 0, 1); PG8_STAGE(PG8_SB(0, 0), b2, voffB); PG8_STAGE(PG8_SB(0, 1), b2 + hstep, voffB); PG8_STAGE(PG8_SA(0, 0), a2, voffA);
            PG8_WAIT_V(8); PG8_WAIT_L(0); PG8_BAR; PG8_MMA(1, 0, At, B0); PG8_MMA(1, 1, At, B1); PG8_BAR; PG8_SCHED;
            PG8_LDB(B0, 1, 0); PG8_LDB(B1, 1, 1); PG8_SCHED; PG8_LDA(At, 1, 0); PG8_STAGE(PG8_SA(0, 1), a2 + hstepA, voffA);
            PG8_WAIT_V(8); PG8_WAIT_L(0); PG8_BAR; PG8_MMA(0, 0, At, B0); PG8_MMA(0, 1, At, B1); PG8_BAR; PG8_SCHED;
            PG8_LDA(At, 1, 1); PG8_STAGE(PG8_SB(1, 0), b3, voffB); PG8_STAGE(PG8_SB(1, 1), b3 + hstep, voffB); PG8_STAGE(PG8_SA(1, 0), a3, voffA);
            PG8_WAIT_V(8); PG8_WAIT_L(0); PG8_BAR; PG8_MMA(1, 0, At, B0); PG8_MMA(1, 1, At, B1); PG8_BAR; PG8_SCHED;
            } else {
            PG8_LDB(B0, 0, 0); PG8_SCHED; PG8_LDA(At, 0, 0); PG8_STAGE(PG8_SA(1, 1), a1 + hstepA, voffA);
            PG8_WAIT_L(8); PG8_BAR; PG8_WAIT_L(0); PG8_MMA(0, 0, At, B0); PG8_BAR; PG8_SCHED;
            PG8_LDB(B1, 0, 1); PG8_STAGE(PG8_SB(0, 0), b2, voffB);
            PG8_BAR; PG8_WAIT_L(0); PG8_MMA(0, 1, At, B1); PG8_BAR;
            PG8_LDA(At, 0, 1); PG8_STAGE(PG8_SA(0, 0), a2, voffA);
            PG8_BAR; PG8_WAIT_L(0); PG8_MMA(1, 0, At, B0); PG8_BAR; PG8_SCHED;
            PG8_STAGE(PG8_SB(0, 1), b2 + hstep, voffB);
            PG8_WAIT_V(6); PG8_BAR; PG8_MMA(1, 1, At, B1); PG8_BAR;
            PG8_LDB(B0, 1, 0); PG8_SCHED; PG8_LDA(At, 1, 0); PG8_STAGE(PG8_SA(0, 1), a2 + hstepA, voffA);
            PG8_WAIT_L(8); PG8_BAR; PG8_WAIT_L(0); PG8_MMA(0, 0, At, B0); PG8_BAR; PG8_SCHED;
            PG8_LDB(B1, 1, 1); PG8_STAGE(PG8_SB(1, 0), b3, voffB);
            PG8_BAR; PG8_WAIT_L(0); PG8_MMA(0, 1, At, B1); PG8_BAR;
            PG8_LDA(At, 1, 1); PG8_STAGE(PG8_SA(1, 0), a3, voffA);
            PG8_BAR; PG8_WAIT_L(0); PG8_MMA(1, 0, At, B0); PG8_BAR; PG8_SCHED;
            PG8_STAGE(PG8_SB(1, 1), b3 + hstep, voffB);
            PG8_WAIT_V(6); PG8_BAR; PG8_MMA(1, 1, At, B1); PG8_BAR;
            }
        }
        if constexpr (ALIGN_EPI) { if (wr == 0) PG8_BAR; }
        if constexpr (!Epi::AFTER_DRAIN) { E(acc, cur, wr, wc, fr, fq); S.done(cur); }
        if (!has_next) break;
#pragma unroll
        for (int a = 0; a < 2; ++a)
#pragma unroll
            for (int b = 0; b < 2; ++b)
#pragma unroll
                for (int m = 0; m < 4; ++m)
#pragma unroll
                    for (int n = 0; n < 2; ++n) acc[a][b][m][n] = (f32x4){0.f, 0.f, 0.f, 0.f};
        cur = nxt; cA = nA; cB = nB; ++ui;
        if constexpr (ALIGN_EPI) { if (wr == 1) PG8_BAR; }
    }
    PG8_WAIT_V(0);
    if constexpr (!ALIGN_EPI) { if (wr == 0) PG8_BAR; }
    PG8_BAR;
    if constexpr (Epi::AFTER_DRAIN) { E.fused(acc, cur, wr, wc, fr, fq, lds, wid, lane); S.done(cur); }
#undef PG8_SA
#undef PG8_AOFF
#undef PG8_SB
#undef PG8_STAGE
#undef PG8_LDA
#undef PG8_LDB
#undef PG8_MMA
#undef PG8_WAIT_V
#undef PG8_WAIT_L
#undef PG8_BAR
#undef PG8_SCHED
}
}

#ifndef MK_N_LAUNCHES
#define MK_N_LAUNCHES 1
#endif
constexpr int NWAVES = 8;
constexpr int BATCH = 8, T = 4096, D = 1024, M = BATCH * T;
constexpr int NPROJ = 2840, NP = 3072;
constexpr int DFF = 2816, NGU = 2 * DFF;
constexpr int COL_Q = 0, COL_KC = 512, COL_VC = 640, COL_KS = 768, COL_VS = 896, COL_KW = 1024, COL_VW = 1152, COL_G = 1280, COL_BG = 1304, COL_CG = 1816, COL_U = 2328;
constexpr float EPS = 1e-6f;
constexpr float LOG2E = 1.4426950408889634f;

constexpr size_t MiB = 1u << 20;
constexpr size_t WS_CTL = 0;
constexpr size_t WS_WIN = 2 * MiB, WS_WOUT = 8 * MiB, WS_WGU = 10 * MiB, WS_WDN = 21 * MiB;
constexpr size_t WS_WC1K = 27 * MiB, WS_WC1V = 27 * MiB + 512 * 1024;
constexpr size_t WS_KCMP = 28 * MiB, WS_VCMPT = 28 * MiB + 512 * 1024, WS_SSA = 29 * MiB, WS_CB = 29 * MiB + 512 * 1024;
constexpr size_t WS_XN = 32 * MiB, WS_MIX = 96 * MiB, WS_P = 160 * MiB;
constexpr size_t WS_VTS = 352 * MiB, WS_VTW = 360 * MiB, WS_OATT = 368 * MiB;
constexpr size_t WS_ACT = 160 * MiB, WS_END = 400 * MiB;
static_assert(WS_P + (size_t)M * NP * 2 <= WS_VTS && WS_ACT + (size_t)M * DFF * 2 <= WS_END && WS_OATT + (size_t)M * 512 * 2 <= WS_END, "ws map");

constexpr int CW_BAR = 4096;
constexpr size_t CTL_ZERO_BYTES = 65536;
constexpr int RING_BYTES = 131072;
constexpr int BARLDS_OFF = RING_BYTES + 512;
constexpr int LDS_BYTES = 147456;

#define LAS __attribute__((address_space(3)))
typedef unsigned short bf16;
typedef unsigned u32x4 __attribute__((ext_vector_type(4)));
typedef unsigned u32x2 __attribute__((ext_vector_type(2)));
typedef float f32x4 __attribute__((ext_vector_type(4)));
typedef float f32x2 __attribute__((ext_vector_type(2)));
typedef short bf16x8 __attribute__((ext_vector_type(8)));
typedef short s16x4 __attribute__((ext_vector_type(4)));
typedef __bf16 bf16x2_t __attribute__((ext_vector_type(2)));

__device__ __forceinline__ unsigned pk2(float lo, float hi) { f32x2 v = {lo, hi}; bf16x2_t b = __builtin_convertvector(v, bf16x2_t); return __builtin_bit_cast(unsigned, b); }
__device__ __forceinline__ float bf_lo(unsigned u) { return __uint_as_float(u << 16); }
__device__ __forceinline__ float bf_hi(unsigned u) { return __uint_as_float(u & 0xffff0000u); }
__device__ __forceinline__ float bf1(bf16 u) { return __uint_as_float((unsigned)u << 16); }
__device__ __forceinline__ float wave_sum(float v) {
#pragma unroll
    for (int o = 1; o < 64; o <<= 1) v += __shfl_xor(v, o);
    return v;
}
__device__ __forceinline__ float sigmoidf_(float x) { return 1.0f / (1.0f + __expf(-x)); }

struct Args { const float* in[20]; float* out; unsigned char* ws; int ph_lo, ph_hi; };

__device__ __forceinline__ void p0_transpose_item(const float* W, int K, int Nsrc, bf16* WT, int row_off, LAS float* scr, int item, int nblk, int lane) {
    const int kb = item / nblk, nb = item % nblk, k0 = 64 * kb, n0 = 32 * nb;
    const int n = n0 + (lane & 31);
#pragma unroll 8
    for (int i = 0; i < 32; ++i) { const int kk = 2 * i + (lane >> 5); scr[kk * 33 + (lane & 31)] = (n < Nsrc) ? W[(size_t)(k0 + kk) * Nsrc + n] : 0.f; }
    asm volatile("s_waitcnt lgkmcnt(0)" ::: "memory");
    const int c = lane & 7;
#pragma unroll
    for (int j = 0; j < 4; ++j) { const int nn = (lane >> 3) + 8 * j; const LAS float* s = scr + (8 * c) * 33 + nn;
        u32x4 o; o.x = pk2(s[0 * 33], s[1 * 33]); o.y = pk2(s[2 * 33], s[3 * 33]); o.z = pk2(s[4 * 33], s[5 * 33]); o.w = pk2(s[6 * 33], s[7 * 33]);
        *(u32x4*)(WT + (size_t)(row_off + n0 + nn) * K + k0 + 8 * c) = o; }
    asm volatile("s_waitcnt lgkmcnt(0)" ::: "memory");
}
__device__ __forceinline__ void rms_row_bf16(const float* xrow, const float* g, bf16* orow, int lane) {
    const f32x4* xr = (const f32x4*)xrow + lane; const f32x4* gr = (const f32x4*)g + lane;
    f32x4 v[4]; float s = 0.f;
#pragma unroll
    for (int j = 0; j < 4; ++j) { v[j] = xr[64 * j]; s += (v[j].x * v[j].x + v[j].y * v[j].y) + (v[j].z * v[j].z + v[j].w * v[j].w); }
    const float rs = 1.0f / sqrtf(wave_sum(s) * (1.f / D) + EPS);
    u32x2* o8 = (u32x2*)orow + lane;
#pragma unroll
    for (int j = 0; j < 4; ++j) { const f32x4 gg = gr[64 * j]; u32x2 o; o.x = pk2(v[j].x * rs * gg.x, v[j].y * rs * gg.y); o.y = pk2(v[j].z * rs * gg.z, v[j].w * rs * gg.w); o8[64 * j] = o; }
}

__device__ __forceinline__ float gelu_tanh(float x) { const float u = 0.7978845608028654f * (x + 0.044715f * x * x * x); return 0.5f * x * (1.0f + tanhf(u)); }

__device__ __forceinline__ void compress_item(const Args& a, LAS unsigned char* lds, int item, int tid) {
    const int lane = tid & 63, w = __builtin_amdgcn_readfirstlane(tid >> 6), r16 = lane & 15, kq = lane >> 4;
    const int kv = item >> 7, b = (item >> 4) & 7, h = (item >> 3) & 1, ib = item & 7;
    unsigned char* ws = a.ws;
    const bf16* P = (const bf16*)(ws + WS_P);
    const bf16* W1T = (const bf16*)(ws + (kv ? WS_WC1V : WS_WC1K));
    const float* w2 = a.in[kv ? 8 : 5];
    LAS unsigned char* Al = lds;
    LAS float* hid = (LAS float*)(lds + 67584);
    const int col0 = (kv ? COL_VC : COL_KC) + h * 64;
    for (int idx = tid; idx < 528 * 8; idx += 512) {
        const int tau = idx >> 3, c = idx & 7; int tok = 512 * ib + tau; tok = tok < T ? tok : T - 1;
        const u32x4 v = *(const u32x4*)(P + (size_t)(b * T + tok) * NP + col0 + 8 * c);
        *(LAS u32x4*)(Al + tau * 128 + ((c ^ ((tau >> 4) & 7)) << 4)) = v;
    }
    __syncthreads();
    f32x4 acc0 = {0.f, 0.f, 0.f, 0.f}, acc1 = {0.f, 0.f, 0.f, 0.f};
    const bf16* wrow = W1T + (size_t)(16 * w + r16) * 2048 + 8 * kq;
#pragma unroll 8
    for (int s = 0; s < 64; ++s) {
        const bf16x8 af = *(const bf16x8*)(wrow + 32 * s);
        const int l = s >> 1, c = (s & 1) * 4 + kq;
        const int tau0 = 16 * r16 + l, tau1 = tau0 + 256;
        const bf16x8 b0 = *(const LAS bf16x8*)(Al + tau0 * 128 + ((c ^ ((tau0 >> 4) & 7)) << 4));
        const bf16x8 b1 = *(const LAS bf16x8*)(Al + tau1 * 128 + ((c ^ ((tau1 >> 4) & 7)) << 4));
        acc0 = __builtin_amdgcn_mfma_f32_16x16x32_bf16(af, b0, acc0, 0, 0, 0);
        acc1 = __builtin_amdgcn_mfma_f32_16x16x32_bf16(af, b1, acc1, 0, 0, 0);
    }
#pragma unroll
    for (int j = 0; j < 4; ++j) { const int n = 16 * w + 4 * kq + j; const float bs = ((const float*)(ws + WS_CB))[kv * 128 + n];
        hid[r16 * 129 + n] = gelu_tanh(acc0[j] + bs); hid[(16 + r16) * 129 + n] = gelu_tanh(acc1[j] + bs); }
    __syncthreads();
    {
        const int i = tid >> 4, d4 = (tid & 15) * 4; f32x4 o = {0.f, 0.f, 0.f, 0.f};
#pragma unroll 8
        for (int n = 0; n < 128; ++n) { const float hv = hid[i * 129 + n]; const f32x4 wv = *(const f32x4*)(w2 + n * 64 + d4); o += hv * wv; }
        const int ig = 32 * ib + i;
        if (ig == 255) o = (f32x4){0.f, 0.f, 0.f, 0.f};
        if (kv == 0) { bf16* K = (bf16*)(ws + WS_KCMP); u32x2 pk; pk.x = pk2(o.x, o.y); pk.y = pk2(o.z, o.w); *(u32x2*)(K + ((size_t)(b * 2 + h) * 256 + ig) * 64 + d4) = pk; }
        else { bf16* Vt = (bf16*)(ws + WS_VCMPT);
#pragma unroll
            for (int e = 0; e < 4; ++e) Vt[((size_t)(b * 2 + h) * 64 + d4 + e) * 256 + ig] = (bf16)(pk2(o[e], 0.f) & 0xffffu); }
    }
    __syncthreads();
}

__device__ __forceinline__ void vtrans_item(const Args& a, LAS unsigned char* lds, int item, int tid) {
    const int which = item >> 10, b = (item >> 7) & 7, hk = (item >> 6) & 1, tt = item & 63;
    const bf16* P = (const bf16*)(a.ws + WS_P);
    bf16* VT = (bf16*)(a.ws + (which ? WS_VTW : WS_VTS));
    const int r = tid >> 3, c = tid & 7;
    const u32x4 v = *(const u32x4*)(P + (size_t)(b * T + 64 * tt + r) * NP + (which ? COL_VW : COL_VS) + hk * 64 + 8 * c);
    *(LAS u32x4*)(lds + r * 144 + c * 16) = v;
    __syncthreads();
    const int d = tid >> 3;
    unsigned short e[8];
#pragma unroll
    for (int j = 0; j < 8; ++j) e[j] = *(const LAS unsigned short*)(lds + (8 * c + j) * 144 + d * 2);
    u32x4 o; o.x = e[0] | ((unsigned)e[1] << 16); o.y = e[2] | ((unsigned)e[3] << 16); o.z = e[4] | ((unsigned)e[5] << 16); o.w = e[6] | ((unsigned)e[7] << 16);
    *(u32x4*)(VT + ((size_t)(b * 2 + hk) * 64 + d) * T + 64 * tt + 8 * c) = o;
    __syncthreads();
}

__device__ __forceinline__ void conv_row(const Args& a, int m, int lane) {
    const bf16* P = (const bf16*)(a.ws + WS_P); bf16* MIX = (bf16*)(a.ws + WS_MIX);
    const float* cw = a.in[9]; const float* gn = a.in[11];
    const int t = m & (T - 1), ch = 8 * lane;
    const bf16* row = P + (size_t)m * NP;
    float y[8];
#pragma unroll
    for (int e = 0; e < 8; ++e) y[e] = 0.f;
#pragma unroll
    for (int k = 0; k < 3; ++k) {
        const int dt = 2 - k;
        if (t - dt >= 0) {
            const u32x4 cv = *(const u32x4*)(row - (size_t)dt * NP + COL_CG + ch), uv = *(const u32x4*)(row - (size_t)dt * NP + COL_U + ch);
            const f32x4 w0 = *(const f32x4*)(cw + k * 512 + ch), w1 = *(const f32x4*)(cw + k * 512 + ch + 4);
            y[0] += w0.x * bf_lo(cv.x) * bf_lo(uv.x); y[1] += w0.y * bf_hi(cv.x) * bf_hi(uv.x);
            y[2] += w0.z * bf_lo(cv.y) * bf_lo(uv.y); y[3] += w0.w * bf_hi(cv.y) * bf_hi(uv.y);
            y[4] += w1.x * bf_lo(cv.z) * bf_lo(uv.z); y[5] += w1.y * bf_hi(cv.z) * bf_hi(uv.z);
            y[6] += w1.z * bf_lo(cv.w) * bf_lo(uv.w); y[7] += w1.w * bf_hi(cv.w) * bf_hi(uv.w);
        }
    }
    const u32x4 bv = *(const u32x4*)(row + COL_BG + ch);
    y[0] *= bf_lo(bv.x); y[1] *= bf_hi(bv.x); y[2] *= bf_lo(bv.y); y[3] *= bf_hi(bv.y); y[4] *= bf_lo(bv.z); y[5] *= bf_hi(bv.z); y[6] *= bf_lo(bv.w); y[7] *= bf_hi(bv.w);
    float s = 0.f;
#pragma unroll
    for (int e = 0; e < 8; ++e) s += y[e] * y[e];
    const float rs = 1.0f / sqrtf(wave_sum(s) * (1.f / 512.f) + EPS);
    const f32x4 g0 = *(const f32x4*)(gn + ch), g1 = *(const f32x4*)(gn + ch + 4);
    u32x4 o; o.x = pk2(y[0] * rs * g0.x, y[1] * rs * g0.y); o.y = pk2(y[2] * rs * g0.z, y[3] * rs * g0.w); o.z = pk2(y[4] * rs * g1.x, y[5] * rs * g1.y); o.w = pk2(y[6] * rs * g1.z, y[7] * rs * g1.w);
    *(u32x4*)(MIX + (size_t)m * D + 512 + ch) = o;
}

constexpr int AL_K0 = 0, AL_V0 = 18432, AL_IMP = 36864, AL_SELM = 54272, AL_WUN = 54784, AL_CTL = 54848, AL_OUT = 55296;
constexpr int TPITCH = 144;
constexpr int IMPP = 68;

struct TileRegs { u32x4 k, v; };
__device__ __forceinline__ TileRegs tile_load(const bf16* kb, unsigned kp, const bf16* vb, unsigned vp, int tid) {
    int r = tid >> 3, c = tid & 7; TileRegs t;
    asm volatile("" : "+v"(r), "+v"(c));
    const unsigned ko = ((unsigned)r * kp + 8u * (unsigned)c) * 2u, vo = ((unsigned)r * vp + 8u * (unsigned)c) * 2u;
    t.k = *(const u32x4*)((const char*)kb + ko); t.v = *(const u32x4*)((const char*)vb + vo); return t;
}
__device__ __forceinline__ void tile_store(LAS unsigned char* lds, int buf, const TileRegs& t, int tid) {
    const int r = tid >> 3, c = tid & 7;
    *(LAS u32x4*)(lds + AL_K0 + buf * 9216 + r * TPITCH + c * 16) = t.k;
    *(LAS u32x4*)(lds + AL_V0 + buf * 9216 + r * TPITCH + c * 16) = t.v;
}

template <int MODE, bool MASKED>
__device__ __forceinline__ void tile_compute(LAS unsigned char* lds, int buf, int pos0, int t, const bf16x8 (&Qf)[2][2], const float (&sl8)[2], const float (&sl2)[2],
                                             float (&mrow)[2], float (&lrow)[2], f32x4 (&O)[2][4], bool selbit, LAS float* improw, int impj0, int lane) {
    const int r16 = lane & 15, kq = lane >> 4;
    const LAS unsigned char* Kb = lds + AL_K0 + buf * 9216; const LAS unsigned char* Vb = lds + AL_V0 + buf * 9216;
    f32x4 st[2][4];
#pragma unroll
    for (int qb = 0; qb < 2; ++qb)
#pragma unroll
        for (int kb = 0; kb < 4; ++kb) st[qb][kb] = (f32x4){0.f, 0.f, 0.f, 0.f};
#pragma unroll
    for (int kb = 0; kb < 4; ++kb) {
#pragma unroll
        for (int ks = 0; ks < 2; ++ks) { const bf16x8 kf = *(const LAS bf16x8*)(Kb + (16 * kb + r16) * TPITCH + (32 * ks + 8 * kq) * 2);
#pragma unroll
            for (int qb = 0; qb < 2; ++qb) st[qb][kb] = __builtin_amdgcn_mfma_f32_16x16x32_bf16(kf, Qf[qb][ks], st[qb][kb], 0, 0, 0); }
        const float kxf = (float)((MODE <= 1 ? 16 : 1) * (16 * kb + r16));
        u32x4 kw; kw.x = (kq == 0) ? pk2(kxf, 0.f) : 0u; kw.y = 0u; kw.z = 0u; kw.w = 0u; const bf16x8 kx = __builtin_bit_cast(bf16x8, kw);
#pragma unroll
        for (int qb = 0; qb < 2; ++qb) { u32x4 qw; qw.x = (kq == 0) ? pk2(sl8[qb], 0.f) : 0u; qw.y = 0u; qw.z = 0u; qw.w = 0u;
            st[qb][kb] = __builtin_amdgcn_mfma_f32_16x16x32_bf16(kx, __builtin_bit_cast(bf16x8, qw), st[qb][kb], 0, 0, 0); }
    }
    __builtin_amdgcn_sched_barrier(0);
    const float sc = 0.125f * LOG2E;
    const int base = (MODE <= 1) ? (t - 16 * pos0 - 31) : (t - pos0);
    float c0[2];
#pragma unroll
    for (int qb = 0; qb < 2; ++qb) { c0[qb] = -sl2[qb] * (float)base; if (MODE == 2 && !selbit) c0[qb] = -1e30f; }
    float tmax[2] = {-1e30f, -1e30f};
#pragma unroll
    for (int qb = 0; qb < 2; ++qb)
#pragma unroll
        for (int kb = 0; kb < 4; ++kb) {
            f32x4 s = st[qb][kb] * sc + c0[qb];
            if (MASKED) {
#pragma unroll
                for (int j = 0; j < 4; ++j) { const int kidx = 16 * kb + 4 * kq + j; const int dist = base - (MODE <= 1 ? 16 : 1) * kidx;
                    const bool v = (MODE == 3) ? ((unsigned)dist < 512u) : (dist >= 0); s[j] = v ? s[j] : -1e30f; }
            }
            st[qb][kb] = s; tmax[qb] = fmaxf(fmaxf(tmax[qb], fmaxf(s[0], s[1])), fmaxf(s[2], s[3]));
        }
    float mnew[2], alpha[2];
#pragma unroll
    for (int qb = 0; qb < 2; ++qb) {
        if (MODE == 1) { mnew[qb] = mrow[qb]; alpha[qb] = 1.f; }
        else { float tm = tmax[qb]; tm = fmaxf(tm, __shfl_xor(tm, 16)); tm = fmaxf(tm, __shfl_xor(tm, 32)); mnew[qb] = fmaxf(mrow[qb], tm); alpha[qb] = __builtin_amdgcn_exp2f(mrow[qb] - mnew[qb]); mrow[qb] = mnew[qb]; }
    }
#pragma unroll
    for (int qb = 0; qb < 2; ++qb) {
        f32x4 ps = {0.f, 0.f, 0.f, 0.f};
#pragma unroll
        for (int kb = 0; kb < 4; ++kb) { f32x4 p = st[qb][kb] - mnew[qb];
#pragma unroll
            for (int j = 0; j < 4; ++j) p[j] = __builtin_amdgcn_exp2f(p[j]);
            if (MODE == 1) p = p * lrow[qb];
            st[qb][kb] = p; ps += p; }
        if (MODE != 1) lrow[qb] = lrow[qb] * alpha[qb] + ((ps[0] + ps[1]) + (ps[2] + ps[3]));
    }
    if (MODE == 0) return;
    if (MODE == 1) {
#pragma unroll
        for (int kb = 0; kb < 4; ++kb) {
            float vm = (st[0][kb][0] + st[0][kb][1]) + (st[0][kb][2] + 0.5f * st[0][kb][3]) + (st[1][kb][0] + st[1][kb][1]) + (st[1][kb][2] + 0.5f * st[1][kb][3]);
            float vh = 0.5f * st[0][kb][3] + 0.5f * st[1][kb][3];
            vm += __shfl_xor(vm, 8); vh += __shfl_xor(vh, 8);
            const int jj = impj0 + 4 * kb + kq;
            if ((lane & 8) == 0) { improw[jj] += vm; }
            if ((lane & 8) == 0) { improw[jj + 1] += vh; }
        }
    }
    if (MODE >= 2) {
#pragma unroll
        for (int qb = 0; qb < 2; ++qb)
#pragma unroll
            for (int db = 0; db < 4; ++db) O[qb][db] *= alpha[qb];
    }
    bf16x8 Pf[2][2];
#pragma unroll
    for (int qb = 0; qb < 2; ++qb)
#pragma unroll
        for (int s2 = 0; s2 < 2; ++s2) { u32x4 w; w.x = pk2(st[qb][2 * s2][0], st[qb][2 * s2][1]); w.y = pk2(st[qb][2 * s2][2], st[qb][2 * s2][3]);
            w.z = pk2(st[qb][2 * s2 + 1][0], st[qb][2 * s2 + 1][1]); w.w = pk2(st[qb][2 * s2 + 1][2], st[qb][2 * s2 + 1][3]); Pf[qb][s2] = __builtin_bit_cast(bf16x8, w); }
    __builtin_amdgcn_sched_barrier(0);
#pragma unroll
    for (int db = 0; db < 4; ++db)
#pragma unroll
        for (int s2 = 0; s2 < 2; ++s2) {
            const u32x2 lo = *(const LAS u32x2*)(Vb + (16 * db + r16) * TPITCH + (32 * s2 + 4 * kq) * 2);
            const u32x2 hi = *(const LAS u32x2*)(Vb + (16 * db + r16) * TPITCH + (32 * s2 + 16 + 4 * kq) * 2);
            u32x4 w; w.x = lo.x; w.y = lo.y; w.z = hi.x; w.w = hi.y; const bf16x8 vf = __builtin_bit_cast(bf16x8, w);
#pragma unroll
            for (int qb = 0; qb < 2; ++qb) O[qb][db] = __builtin_amdgcn_mfma_f32_16x16x32_bf16(vf, Pf[qb][s2], O[qb][db], 0, 0, 0);
        }
}

__device__ __forceinline__ void attn_item(const Args& a, LAS unsigned char* lds, int it, int tid) {
    const int lane = tid & 63, w = __builtin_amdgcn_readfirstlane(tid >> 6), r16 = lane & 15, kq = lane >> 4, tql = r16 & 7, gl = r16 >> 3;
    const int c = 63 - (it >> 4), b = (it >> 1) & 7, hk = it & 1;
    unsigned char* ws = a.ws;
    const bf16* P = (const bf16*)(ws + WS_P);
    const bf16* KC = (const bf16*)(ws + WS_KCMP) + (size_t)(b * 2 + hk) * 256 * 64;
    const bf16* VCT = (const bf16*)(ws + WS_VCMPT) + (size_t)(b * 2 + hk) * 64 * 256;
    const bf16* VTS = (const bf16*)(ws + WS_VTS) + (size_t)(b * 2 + hk) * 64 * T;
    const bf16* VTW = (const bf16*)(ws + WS_VTW) + (size_t)(b * 2 + hk) * 64 * T;
    const bf16* PKS = P + (size_t)b * T * NP + COL_KS + hk * 64;
    const bf16* PKW = P + (size_t)b * T * NP + COL_KW + hk * 64;
    const int tq = 8 * w + tql, t = 64 * c + tq; const size_t R = (size_t)b * T + t;
    LAS float* imp = (LAS float*)(lds + AL_IMP); LAS unsigned* selm = (LAS unsigned*)(lds + AL_SELM); LAS unsigned* wunl = (LAS unsigned*)(lds + AL_WUN);
    LAS float* improw = imp + tq * IMPP;

    bf16x8 Qf[2][2]; float sl2[2], sl8[2];
#pragma unroll
    for (int qb = 0; qb < 2; ++qb) { const int hq = hk * 4 + 2 * qb + gl; sl2[qb] = LOG2E * exp2f(-(float)(hq + 1));
        sl8[qb] = exp2f((float)(2 - hq));
#pragma unroll
        for (int ks = 0; ks < 2; ++ks) Qf[qb][ks] = *(const bf16x8*)(P + R * NP + COL_Q + hq * 64 + 32 * ks + 8 * kq); }
    LAS float* outl = (LAS float*)(lds + AL_OUT) + tid;
#define GATE(qb, br) sigmoidf_(bf1(P[R * NP + COL_G + hk * 12 + (2 * (qb) + gl) * 3 + (br)]))
    for (int i = lane; i < 8 * IMPP; i += 64) imp[(8 * w) * IMPP + i] = 0.f;

    f32x4 O[2][4];
#pragma unroll
    for (int qb = 0; qb < 2; ++qb)
#pragma unroll
        for (int db = 0; db < 4; ++db) O[qb][db] = (f32x4){0.f, 0.f, 0.f, 0.f};
    float mrow[2] = {-1e25f, -1e25f}, lrow[2] = {0.f, 0.f};
    int buf = 0;
    TileRegs tr;

    const int nct = (4 * c + 3 + 63) >> 6;
    tr = tile_load(KC, 64, VCT, 256, tid);
    for (int ti = 0; ti < nct; ++ti) {
        tile_store(lds, buf, tr, tid); __syncthreads();
        { const int nx = (ti + 1 < nct) ? ti + 1 : 0; tr = tile_load(KC + (size_t)nx * 64 * 64, 64, VCT + nx * 64, 256, tid); }
        if (16 * (64 * ti + 63) + 31 <= 64 * c) tile_compute<0, false>(lds, buf, 64 * ti, t, Qf, sl8, sl2, mrow, lrow, O, true, improw, 0, lane);
        else tile_compute<0, true>(lds, buf, 64 * ti, t, Qf, sl8, sl2, mrow, lrow, O, true, improw, 0, lane);
        buf ^= 1;
    }
#pragma unroll
    for (int qb = 0; qb < 2; ++qb) { float l = lrow[qb]; l += __shfl_xor(l, 16); l += __shfl_xor(l, 32); lrow[qb] = l > 0.f ? 1.0f / l : 0.f; }
    for (int ti = 0; ti < nct; ++ti) {
        tile_store(lds, buf, tr, tid); __syncthreads();
        if (ti + 1 < nct) tr = tile_load(KC + (size_t)(ti + 1) * 64 * 64, 64, VCT + (ti + 1) * 64, 256, tid);
        if (16 * (64 * ti + 63) + 31 <= 64 * c) tile_compute<1, false>(lds, buf, 64 * ti, t, Qf, sl8, sl2, mrow, lrow, O, true, improw, 16 * ti, lane);
        else tile_compute<1, true>(lds, buf, 64 * ti, t, Qf, sl8, sl2, mrow, lrow, O, true, improw, 16 * ti, lane);
        buf ^= 1;
    }
#pragma unroll
    for (int qb = 0; qb < 2; ++qb) { const float g0 = GATE(qb, 0);
#pragma unroll
        for (int db = 0; db < 4; ++db) {
#pragma unroll
            for (int e = 0; e < 4; ++e) outl[((qb * 4 + db) * 4 + e) * 512] = g0 * O[qb][db][e];
            O[qb][db] = (f32x4){0.f, 0.f, 0.f, 0.f}; } }

    unsigned long long wun = 0ull;
    for (int tt = 0; tt < 8; ++tt) {
        LAS float* row = imp + (8 * w + tt) * IMPP;
        int ln = lane; asm volatile("" : "+v"(ln));
        float mine = row[ln];
        if (ln == 0 || ln == c || ln == c - 1) mine = 1e30f;
        if (ln > c) mine = -1e30f;
        row[ln] = mine;
        int rank = 0;
#pragma unroll
        for (int i4 = 0; i4 < 16; ++i4) { const f32x4 v = *(const LAS f32x4*)(row + 4 * i4);
#pragma unroll
            for (int e = 0; e < 4; ++e) { const int i = 4 * i4 + e; rank += ((v[e] > mine) || (v[e] == mine && i < ln)) ? 1 : 0; } }
        const bool sel = (rank < 16) && (ln <= c);
        const unsigned long long mk = __ballot(sel);
        wun |= mk;
        if (lane == 0) { selm[(8 * w + tt) * 2] = (unsigned)mk; selm[(8 * w + tt) * 2 + 1] = (unsigned)(mk >> 32); }
    }
    if (lane == 0) { wunl[2 * w] = (unsigned)wun; wunl[2 * w + 1] = (unsigned)(wun >> 32); }
    const unsigned long long mysel = (unsigned long long)selm[tq * 2] | ((unsigned long long)selm[tq * 2 + 1] << 32);
    __syncthreads();
    unsigned long long uni = 0ull;
#pragma unroll
    for (int i = 0; i < 8; ++i) uni |= (unsigned long long)wunl[2 * i] | ((unsigned long long)wunl[2 * i + 1] << 32);
    uni = ((unsigned long long)__builtin_amdgcn_readfirstlane((unsigned)(uni >> 32)) << 32) | (unsigned long long)__builtin_amdgcn_readfirstlane((unsigned)uni);

    mrow[0] = mrow[1] = -1e25f; lrow[0] = lrow[1] = 0.f;
    {
        int j = __builtin_ctzll(uni);
        tr = tile_load(PKS + (size_t)(64 * j) * NP, NP, VTS + 64 * j, T, tid);
        while (uni) {
            j = __builtin_ctzll(uni); uni &= uni - 1;
            tile_store(lds, buf, tr, tid); __syncthreads();
            if (uni) { const int jn = __builtin_ctzll(uni); tr = tile_load(PKS + (size_t)(64 * jn) * NP, NP, VTS + 64 * jn, T, tid); }
            if ((wun >> j) & 1ull) { const bool sb = ((mysel >> j) & 1ull) != 0ull;
                if (j < c) tile_compute<2, false>(lds, buf, 64 * j, t, Qf, sl8, sl2, mrow, lrow, O, sb, improw, 0, lane);
                else tile_compute<2, true>(lds, buf, 64 * j, t, Qf, sl8, sl2, mrow, lrow, O, sb, improw, 0, lane); }
            buf ^= 1;
        }
    }
#pragma unroll
    for (int qb = 0; qb < 2; ++qb) { float l = lrow[qb]; l += __shfl_xor(l, 16); l += __shfl_xor(l, 32); const float inv = (l > 0.f ? 1.0f / l : 0.f) * GATE(qb, 1);
#pragma unroll
        for (int db = 0; db < 4; ++db) {
#pragma unroll
            for (int e = 0; e < 4; ++e) outl[((qb * 4 + db) * 4 + e) * 512] += inv * O[qb][db][e];
            O[qb][db] = (f32x4){0.f, 0.f, 0.f, 0.f}; } }

    mrow[0] = mrow[1] = -1e25f; lrow[0] = lrow[1] = 0.f;
    {
        const int j0 = c >= 8 ? c - 8 : 0;
        tr = tile_load(PKW + (size_t)(64 * j0) * NP, NP, VTW + 64 * j0, T, tid);
        for (int j = j0; j <= c; ++j) {
            tile_store(lds, buf, tr, tid); __syncthreads();
            if (j < c) tr = tile_load(PKW + (size_t)(64 * (j + 1)) * NP, NP, VTW + 64 * (j + 1), T, tid);
            if (j < c && j > c - 8) tile_compute<3, false>(lds, buf, 64 * j, t, Qf, sl8, sl2, mrow, lrow, O, true, improw, 0, lane);
            else tile_compute<3, true>(lds, buf, 64 * j, t, Qf, sl8, sl2, mrow, lrow, O, true, improw, 0, lane);
            buf ^= 1;
        }
    }
    float ss = 0.f;
    bf16* OA = (bf16*)(ws + WS_OATT);
#pragma unroll
    for (int qb = 0; qb < 2; ++qb) { float l = lrow[qb]; l += __shfl_xor(l, 16); l += __shfl_xor(l, 32); const float inv = (l > 0.f ? 1.0f / l : 0.f) * GATE(qb, 2);
#pragma unroll
        for (int db = 0; db < 4; ++db) { f32x4 o;
#pragma unroll
            for (int e = 0; e < 4; ++e) o[e] = outl[((qb * 4 + db) * 4 + e) * 512] + inv * O[qb][db][e];
            ss += (o.x * o.x + o.y * o.y) + (o.z * o.z + o.w * o.w);
            u32x2 pk; pk.x = pk2(o.x, o.y); pk.y = pk2(o.z, o.w);
            *(u32x2*)(OA + R * 512 + hk * 256 + (2 * qb + gl) * 64 + 16 * db + 4 * kq) = pk; } }
    ss += __shfl_xor(ss, 8); ss += __shfl_xor(ss, 16); ss += __shfl_xor(ss, 32);
    if (lane < 8) ((float*)(ws + WS_SSA))[R * 2 + hk] = ss;
    __syncthreads();
#undef GATE
}


#define RLX_AGENT __ATOMIC_RELAXED, __HIP_MEMORY_SCOPE_AGENT
#define XB_TMO      128
#define XB_XCNT(j)  (256  + 64 * (j))
#define XB_XSUB(j)  (1280 + 64 * (j))
#define XB_XGEN(j)  (2304 + 64 * (j))
#define XB_TOP      3328
#define XB_TOPGEN   3392
#define XCD_BAR_WORDS 3456
#define XB_SPIN_CAP (1u << 18)

__device__ __forceinline__ unsigned xb_ld(unsigned* p)              { return __hip_atomic_load(p, __ATOMIC_RELAXED, __HIP_MEMORY_SCOPE_AGENT); }
__device__ __forceinline__ unsigned xb_add(unsigned* p, unsigned v) { return __hip_atomic_fetch_add(p, v, __ATOMIC_RELAXED, __HIP_MEMORY_SCOPE_AGENT); }
__device__ __forceinline__ unsigned xb_xcc_id() { return (unsigned)__builtin_amdgcn_s_getreg((3 << 11) | 20) & 0xFu; }
#define XB_SPIN(cond, bar) do { unsigned _sp = 0; while (cond) { __builtin_amdgcn_s_sleep(1); \
    if ((++_sp & 255u) == 0u) { if (xb_ld(&(bar)[XB_TMO])) break; if (_sp > XB_SPIN_CAP) { atomicAdd(&(bar)[XB_TMO], 1u); break; } } } } while (0)

struct XcdBarrier {
    unsigned* bar; unsigned x;
    volatile LAS unsigned* st;
};

__device__ __forceinline__ XcdBarrier xcd_barrier_post(unsigned* bar, volatile LAS unsigned* st) {
    XcdBarrier b; b.bar = bar; b.x = xb_xcc_id(); b.st = st;
    if (threadIdx.x == 0) (void)xb_add(&bar[XB_XCNT(b.x)], 1u);
    return b;
}
__device__ __forceinline__ void xcd_barrier_complete(unsigned* bar, unsigned x, unsigned& nloc, unsigned& nx) {
    const unsigned G = gridDim.x * gridDim.y * gridDim.z;
    unsigned sum, cnt, mine, sp = 0u;
    for (;;) {
        sum = 0u; cnt = 0u; mine = 0u;
#pragma unroll
        for (unsigned j = 0; j < 16; ++j) { const unsigned c = xb_ld(&bar[XB_XCNT(j)]); sum += c; cnt += (c > 0u) ? 1u : 0u; mine = (j == x) ? c : mine; }
        if (sum == G) break;
        __builtin_amdgcn_s_sleep(1);
        if ((++sp & 255u) == 0u) { if (xb_ld(&bar[XB_TMO])) break; if (sp > XB_SPIN_CAP) { atomicAdd(&bar[XB_TMO], 1u); break; } }
    }
    nloc = mine > 0u ? mine : 1u; nx = cnt > 0u ? cnt : 1u;
}

__device__ __forceinline__ void xcd_barrier(const XcdBarrier& b) {
    asm volatile("s_waitcnt vmcnt(0)" ::: "memory");
    __syncthreads();
    if (threadIdx.x == 0) {
        unsigned* bar = b.bar;
        __builtin_amdgcn_s_waitcnt(0);
        unsigned nloc = b.st[0], nx = b.st[1];
        if (nloc == 0u) { xcd_barrier_complete(bar, b.x, nloc, nx); b.st[0] = nloc; b.st[1] = nx; }
        const unsigned old = xb_add(&bar[XB_XSUB(b.x)], 1u);
        const unsigned gen = old / nloc;
        if (old + 1u == (gen + 1u) * nloc) {
            __builtin_amdgcn_fence(__ATOMIC_RELEASE, "agent");
            asm volatile("s_waitcnt vmcnt(0)" ::: "memory");
            const unsigned og = xb_add(&bar[XB_TOP], 1u);
            const unsigned tg = og / nx;
            if (og + 1u == (tg + 1u) * nx) xb_add(&bar[XB_TOPGEN], 1u);
            else XB_SPIN(xb_ld(&bar[XB_TOPGEN]) == tg, bar);
            __builtin_amdgcn_fence(__ATOMIC_ACQUIRE, "agent");
            xb_add(&bar[XB_XGEN(b.x)], 1u);
            asm volatile("s_waitcnt vmcnt(0)" ::: "memory");
        } else {
            XB_SPIN(xb_ld(&bar[XB_XGEN(b.x)]) == gen, bar);
            __builtin_amdgcn_fence(__ATOMIC_ACQUIRE, "agent");
            asm volatile("s_waitcnt vmcnt(0)" ::: "memory");
        }
    }
    __syncthreads();
}

constexpr int NPHASE = 11;
__global__ void __launch_bounds__(NWAVES * 64, 2) hymba_fwd(Args args) {
    extern __shared__ __attribute__((aligned(16))) unsigned char lds_raw[];
    LAS unsigned char* lds = (LAS unsigned char*)lds_raw;
    cg::grid_group grid = cg::this_grid();
    const int tid = threadIdx.x, lane = tid & 63, wave = __builtin_amdgcn_readfirstlane(tid >> 6);
    const int G = gridDim.x, bx = blockIdx.x;
    const int gw = bx * NWAVES + wave, NGW = G * NWAVES;
    unsigned char* ws = args.ws;
    const int lo = args.ph_lo, hi = args.ph_hi;
#define IN(k) (lo <= (k) && (k) < hi)
    if (tid < 16) ((LAS unsigned*)(lds + BARLDS_OFF))[tid] = 0u;
    __syncthreads();
    XcdBarrier bar = xcd_barrier_post((unsigned*)(ws + WS_CTL) + CW_BAR, (volatile LAS unsigned*)(lds + BARLDS_OFF));
#define SEAM(k) do { if (IN(k) && IN((k) + 1)) { if ((k) == 0) grid.sync(); else xcd_barrier(bar); } } while (0)

    if (IN(0)) {
        LAS float* scr = (LAS float*)(lds + wave * 16384);
        constexpr int I_IN = 16 * 96, I_OUT = 16 * 32, I_G = 16 * 88, I_DN = 44 * 32, I_C1 = 32 * 4;
        constexpr int NITEMS = I_IN + I_OUT + 2 * I_G + I_DN + 2 * I_C1;
        for (int it = gw; it < NITEMS; it += NGW) {
            int r = it;
            if (r < I_IN) { p0_transpose_item(args.in[2], D, NPROJ, (bf16*)(ws + WS_WIN), 0, scr, r, 96, lane); continue; } r -= I_IN;
            if (r < I_OUT) { p0_transpose_item(args.in[12], D, D, (bf16*)(ws + WS_WOUT), 0, scr, r, 32, lane); continue; } r -= I_OUT;
            if (r < I_G) { const int n0 = 32 * (r % 88); p0_transpose_item(args.in[14], D, DFF, (bf16*)(ws + WS_WGU), 256 * (n0 >> 7) + (n0 & 127) - n0, scr, r, 88, lane); continue; } r -= I_G;
            if (r < I_G) { const int n0 = 32 * (r % 88); p0_transpose_item(args.in[15], D, DFF, (bf16*)(ws + WS_WGU), 256 * (n0 >> 7) + 128 + (n0 & 127) - n0, scr, r, 88, lane); continue; } r -= I_G;
            if (r < I_DN) { p0_transpose_item(args.in[18], DFF, D, (bf16*)(ws + WS_WDN), 0, scr, r, 32, lane); continue; } r -= I_DN;
            if (r < I_C1) { p0_transpose_item(args.in[4], 2048, 128, (bf16*)(ws + WS_WC1K), 0, scr, r, 4, lane); continue; } r -= I_C1;
            p0_transpose_item(args.in[7], 2048, 128, (bf16*)(ws + WS_WC1V), 0, scr, r, 4, lane);
        }
        if (gw < 256) {
            const int kv = gw >> 7, n = gw & 127; const float* pos = args.in[kv ? 6 : 3]; const float* w1 = args.in[kv ? 7 : 4]; float s = 0.f;
#pragma unroll 8
            for (int k = lane; k < 2048; k += 64) s += pos[k] * w1[(size_t)k * 128 + n];
            s = wave_sum(s);
            if (lane == 0) ((float*)(ws + WS_CB))[gw] = s;
        }
        for (int m = gw; m < M; m += NGW) rms_row_bf16(args.in[0] + (size_t)m * D, args.in[1], (bf16*)(ws + WS_XN) + (size_t)m * D, lane);
    }
    SEAM(0);
    if (IN(1)) {
        pg8::Gemm g{(const pg8::bf16_t*)(ws + WS_XN), (const pg8::bf16_t*)(ws + WS_WIN), M, NP, D}; pg8::StaticOrder S; S.init(M, NP, G, bx);
        pg8::EpiBf16 E{(pg8::bf16_t*)(ws + WS_P), NP, 0, 0};
        pg8::gemm_phase<pg8::EpiBf16, pg8::StaticOrder, true, true>(lds, g, S, E);
    }
    SEAM(1);
    if (IN(2)) {
        for (int it = bx; it < 256; it += G) compress_item(args, lds, it, tid);
        for (int it = bx; it < 2048; it += G) vtrans_item(args, lds, it, tid);
        for (int m = gw; m < M; m += NGW) conv_row(args, m, lane);
    }
    SEAM(2);
    if (IN(3)) {
        LAS int* ctl = (LAS int*)(lds + AL_CTL);
        for (;;) {
            if (tid == 0) ctl[0] = (int)atomicAdd((unsigned*)(ws + WS_CTL), 1u);
            __syncthreads();
            const int it = ctl[0];
            if (it >= 1024) break;
            attn_item(args, lds, it, tid);
        }
    }
    SEAM(3);
    if (IN(4)) {
        const bf16* OA = (const bf16*)(ws + WS_OATT); const float* ssa = (const float*)(ws + WS_SSA); bf16* MIX = (bf16*)(ws + WS_MIX); const float* gn = args.in[10];
        for (int m = gw; m < M; m += NGW) {
            const float rs = 1.0f / sqrtf((ssa[2 * m] + ssa[2 * m + 1]) * (1.f / 512.f) + EPS);
            const int ch = 8 * lane; const u32x4 v = *(const u32x4*)(OA + (size_t)m * 512 + ch);
            const f32x4 g0 = *(const f32x4*)(gn + ch), g1 = *(const f32x4*)(gn + ch + 4);
            u32x4 o; o.x = pk2(bf_lo(v.x) * rs * g0.x, bf_hi(v.x) * rs * g0.y); o.y = pk2(bf_lo(v.y) * rs * g0.z, bf_hi(v.y) * rs * g0.w);
            o.z = pk2(bf_lo(v.z) * rs * g1.x, bf_hi(v.z) * rs * g1.y); o.w = pk2(bf_lo(v.w) * rs * g1.z, bf_hi(v.w) * rs * g1.w);
            *(u32x4*)(MIX + (size_t)m * D + ch) = o;
        }
    }
    SEAM(4);
    if (IN(5)) {
        pg8::Gemm g{(const pg8::bf16_t*)(ws + WS_MIX), (const pg8::bf16_t*)(ws + WS_WOUT), M, D, D}; pg8::StaticOrder S; S.init(M, D, G, bx);
        pg8::EpiResF32 E{args.in[0], args.out, D};
        pg8::gemm_phase<pg8::EpiResF32, pg8::StaticOrder, true, true>(lds, g, S, E);
    }
    SEAM(5);
    if (IN(6)) {
        for (int m = gw; m < M; m += NGW) rms_row_bf16(args.out + (size_t)m * D, args.in[13], (bf16*)(ws + WS_XN) + (size_t)m * D, lane);
    }
    SEAM(6);
    if (IN(7)) {
        constexpr int NMT = (M + 251) / 252;
        pg8::Gemm g{(const pg8::bf16_t*)(ws + WS_XN), (const pg8::bf16_t*)(ws + WS_WGU), NMT * 256, NGU, D}; pg8::StaticOrder S; S.init(NMT * 256, NGU, G, bx);
        pg8::EpiFfn E{(pg8::bf16_t*)(ws + WS_ACT), args.in[16], args.in[17], M, DFF, T};
        pg8::gemm_phase<pg8::EpiFfn, pg8::StaticOrder, true, true, true>(lds, g, S, E);
    }
    SEAM(7);
    if (IN(9)) {
        pg8::Gemm g{(const pg8::bf16_t*)(ws + WS_ACT), (const pg8::bf16_t*)(ws + WS_WDN), M, D, DFF}; pg8::StaticOrder S; S.init(M, D, G, bx);
        pg8::EpiResF32 E{args.out, args.out, D};
        pg8::gemm_phase<pg8::EpiResF32, pg8::StaticOrder, true, true>(lds, g, S, E);
    }
    SEAM(9);
    if (IN(10)) {
        const float* gn = args.in[19];
        for (int m = gw; m < M; m += NGW) {
            f32x4* xr = (f32x4*)(args.out + (size_t)m * D) + lane; const f32x4* gr = (const f32x4*)gn + lane;
            f32x4 v[4]; float s = 0.f;
#pragma unroll
            for (int j = 0; j < 4; ++j) { v[j] = xr[64 * j]; s += (v[j].x * v[j].x + v[j].y * v[j].y) + (v[j].z * v[j].z + v[j].w * v[j].w); }
            const float rs = 1.0f / sqrtf(wave_sum(s) * (1.f / D) + EPS);
#pragma unroll
            for (int j = 0; j < 4; ++j) xr[64 * j] = v[j] * rs * gr[64 * j];
        }
    }
#undef IN
#undef SEAM
}

extern "C" void kernel_launch(void* const* d_in, const int* in_sizes, int n_in, void* d_out, int out_size, void* d_ws, size_t ws_size, hipStream_t stream) {
    static int grid = 0;
    if (grid == 0) {
        if (n_in != 20 || in_sizes[0] != M * D || out_size != M * D || ws_size < WS_END) { fprintf(stderr, "kernel_launch: unexpected sizes n_in %d in0 %d out %d ws %zu\n", n_in, n_in > 0 ? in_sizes[0] : -1, out_size, ws_size); grid = -1; return; }
        int dev = 0, cus = 0, per_cu = 0;
        hipGetDevice(&dev); hipDeviceGetAttribute(&cus, hipDeviceAttributeMultiprocessorCount, dev);
        if (hipFuncSetAttribute((const void*)hymba_fwd, hipFuncAttributeMaxDynamicSharedMemorySize, LDS_BYTES) != hipSuccess) { fprintf(stderr, "kernel_launch: hipFuncSetAttribute failed\n"); grid = -1; return; }
        if (hipOccupancyMaxActiveBlocksPerMultiprocessor(&per_cu, (const void*)hymba_fwd, NWAVES * 64, LDS_BYTES) != hipSuccess || per_cu < 1) { fprintf(stderr, "kernel_launch: occupancy query says %d\n", per_cu); per_cu = 1; }
        (void)hipGetLastError();
        grid = cus * per_cu;
    }
    if (grid < 0) return;
    if (hipMemsetAsync((char*)d_ws + WS_CTL, 0, CTL_ZERO_BYTES, stream) != hipSuccess) { fprintf(stderr, "kernel_launch: memset failed\n"); return; }
    Args a{};
    for (int i = 0; i < 20; ++i) a.in[i] = (const float*)d_in[i];
    a.out = (float*)d_out; a.ws = (unsigned char*)d_ws;
#if MK_N_LAUNCHES == 1
    a.ph_lo = 0; a.ph_hi = NPHASE;
    void* kargs[] = {&a};
    hipError_t e = hipLaunchCooperativeKernel((const void*)hymba_fwd, dim3(grid), dim3(NWAVES * 64), kargs, LDS_BYTES, stream);
    if (e != hipSuccess) fprintf(stderr, "cooperative launch failed: %s (grid %d)\n", hipGetErrorString(e), grid);
#else
    for (int p = 0; p < NPHASE; ++p) { a.ph_lo = p; a.ph_hi = p + 1; hipLaunchKernelGGL(hymba_fwd, dim3(grid), dim3(NWAVES * 64), LDS_BYTES, stream, a); }
#endif
}
```

```cpp
#include <hip/hip_runtime.h>
#include <hip/hip_cooperative_groups.h>
#include <cstdio>
#include <cstdint>
namespace cg = cooperative_groups;
namespace pg8 {
#define PG8_LAS __attribute__((address_space(3)))
typedef unsigned short bf16_t;
typedef short bf16x8 __attribute__((ext_vector_type(8)));
typedef float f32x4 __attribute__((ext_vector_type(4)));
typedef unsigned u32x4 __attribute__((ext_vector_type(4)));
constexpr int BM = 256, BK = 64, HALF = 128, HTB = HALF * BK * 2  , STAGE_BYTES = 8 * HTB, NXCD = 8, WGM = 8;

__host__ __device__ __forceinline__ int lds_byte(int r, int c) { const int st = (r >> 4) * 2 + (c >> 5), rr = r & 15, cc = c & 31, ob = rr * 64 + cc * 2; return st * 1024 + (ob ^ (((ob >> 9) & 1) << 5)); }
__host__ __device__ __forceinline__ void stage_rc(int b, int& R, int& C) { const int st = b / 1024, sb = b % 1024, swz = sb ^ (((sb >> 9) & 1) << 5); R = (st >> 1) * 16 + swz / 64; C = (st & 1) * 32 + (swz % 64) / 2; }
__host__ __device__ __forceinline__ int perm32(int rho) { const int n = rho >> 4, i = rho & 15; return 8 * (i >> 2) + 4 * n + (i & 3); }

struct Unit { int pm, pn; };
struct Gemm { const bf16_t* A; const bf16_t* Bt; int M, N, K; };

struct StaticOrder {
    int nM, nN, nwg, G, c;
    __host__ __device__ void init(int M, int N, int G_, int c_) { nM = M / BM; nN = N / BM; nwg = nM * nN; G = G_; c = c_; }
    __host__ __device__ bool next(int i, Unit& u) const {
        const long L = (long)i * G + c; if (L >= nwg) return false;
        int wgid = (int)L; { const int q = nwg / NXCD, r = nwg % NXCD, xcd = wgid % NXCD, off = wgid / NXCD; wgid = (xcd < r ? xcd * (q + 1) : r * (q + 1) + (xcd - r) * q) + off; }
        const int nig = WGM * nN, gid = wgid / nig, fm = gid * WGM, gsz = (nM - fm) < WGM ? (nM - fm) : WGM;
        u.pm = fm + ((wgid % nig) % gsz); u.pn = (wgid % nig) / gsz; return true;
    }
    __device__ __forceinline__ void a_ready(const Unit&) const {}
    __device__ __forceinline__ void done(const Unit&) const {}
};

__device__ __forceinline__ unsigned cvt_pk_bf16(float lo, float hi) { unsigned r; asm volatile("v_cvt_pk_bf16_f32 %0, %1, %2" : "=v"(r) : "v"(lo), "v"(hi)); return r; }

struct EpiBf16 {
    static constexpr bool PERM = true, AFTER_DRAIN = false;
    bf16_t* O; int ldc; int split_cols; size_t split_stride;
    __device__ __forceinline__ void operator()(const f32x4 (&acc)[2][2][4][2], const Unit& u, int wr, int wc, int fr, int fq) const {
        const int row0 = u.pm * BM + wr * 64 + fr; int colt = u.pn * BM; bf16_t* base = O;
        if (split_cols) { const int t = colt / split_cols; base += (size_t)t * split_stride; colt -= t * split_cols; }
        const int col0 = colt + wc * 32 + 8 * fq;
#pragma unroll
        for (int ai = 0; ai < 2; ++ai)
#pragma unroll
            for (int m = 0; m < 4; ++m) { bf16_t* rowp = base + (size_t)(row0 + ai * HALF + m * 16) * ldc + col0;
#pragma unroll
                for (int bj = 0; bj < 2; ++bj) { const f32x4 v0 = acc[ai][bj][m][0], v1 = acc[ai][bj][m][1];
                    u32x4 w; w.x = cvt_pk_bf16(v0[0], v0[1]); w.y = cvt_pk_bf16(v0[2], v0[3]); w.z = cvt_pk_bf16(v1[0], v1[1]); w.w = cvt_pk_bf16(v1[2], v1[3]);
                    *(u32x4*)(rowp + bj * HALF) = w; } }
    }
};
struct EpiResF32 {
    static constexpr bool PERM = false, AFTER_DRAIN = false;
    const float* base; float* out; int ldc;
    __device__ __forceinline__ void operator()(const f32x4 (&acc)[2][2][4][2], const Unit& u, int wr, int wc, int fr, int fq) const {
        const int col0 = u.pn * BM + wc * 32 + 4 * fq;
#pragma unroll
        for (int ai = 0; ai < 2; ++ai)
#pragma unroll
            for (int m = 0; m < 4; ++m) { const size_t off = (size_t)(u.pm * BM + ai * HALF + wr * 64 + m * 16 + fr) * ldc + col0;
#pragma unroll
                for (int bj = 0; bj < 2; ++bj)
#pragma unroll
                    for (int n = 0; n < 2; ++n) { const f32x4 bs = *(const f32x4*)(base + off + bj * HALF + n * 16); *(f32x4*)(out + off + bj * HALF + n * 16) = bs + acc[ai][bj][m][n]; } }
    }
};


struct EpiFfn {
    static constexpr bool PERM = true, AFTER_DRAIN = false;
    bf16_t* ACT; const float* cw; const float* cb; int Mrows; int DFFc; int Tseq;
    __device__ __forceinline__ void operator()(const f32x4 (&acc)[2][2][4][2], const Unit& u, int wr, int wc, int fr, int fq) const {
        const int ch0 = u.pn * 128 + wc * 32 + 8 * fq;
        const int rbase = 252 * u.pm - 2 + 126 * wr + 8 * fr;
        f32x4 w0[2], w1[2], w2[2], bb[2];
#pragma unroll
        for (int n = 0; n < 2; ++n) { w0[n] = *(const f32x4*)(cw + ch0 + 4 * n); w1[n] = *(const f32x4*)(cw + DFFc + ch0 + 4 * n); w2[n] = *(const f32x4*)(cw + 2 * DFFc + ch0 + 4 * n); bb[n] = *(const f32x4*)(cb + ch0 + 4 * n); }
        float p6[2][4], p7[2][4];
#pragma unroll
        for (int n = 0; n < 2; ++n)
#pragma unroll
            for (int i = 0; i < 4; ++i) { p7[n][i] = __shfl_up(acc[1][0][3][n][i], 1, 16); p6[n][i] = __shfl_up(acc[1][0][2][n][i], 1, 16); }
#pragma unroll
        for (int k = 0; k < 8; ++k) {
            const int r = rbase + k, tk = r & (Tseq - 1);
            const bool ok = (8 * fr + k >= 2) && (r < Mrows);
            float o[2][4];
#pragma unroll
            for (int n = 0; n < 2; ++n)
#pragma unroll
                for (int i = 0; i < 4; ++i) {
                    const float gk = acc[k >> 2][0][k & 3][n][i];
                    float gm1 = (k >= 1) ? acc[(k >= 1 ? k - 1 : 0) >> 2][0][(k >= 1 ? k - 1 : 0) & 3][n][i] : p7[n][i];
                    float gm2 = (k >= 2) ? acc[(k >= 2 ? k - 2 : 0) >> 2][0][(k >= 2 ? k - 2 : 0) & 3][n][i] : (k == 1 ? p7[n][i] : p6[n][i]);
                    gm1 = tk >= 1 ? gm1 : 0.f; gm2 = tk >= 2 ? gm2 : 0.f;
                    const float gt = w0[n][i] * gm2 + w1[n][i] * gm1 + w2[n][i] * gk + bb[n][i];
                    o[n][i] = gt * (1.0f / (1.0f + __expf(-gt))) * acc[k >> 2][1][k & 3][n][i];
                }
            u32x4 w; w.x = cvt_pk_bf16(o[0][0], o[0][1]); w.y = cvt_pk_bf16(o[0][2], o[0][3]); w.z = cvt_pk_bf16(o[1][0], o[1][1]); w.w = cvt_pk_bf16(o[1][2], o[1][3]);
            if (ok) *(u32x4*)(ACT + (size_t)r * DFFc + ch0) = w;
        }
    }
};

template <class Epi, class Sched, bool ALIGN_EPI = false, bool SP2 = false, bool AMAP = false>
__device__ __forceinline__ void gemm_phase(PG8_LAS unsigned char* lds, const Gemm g, const Sched& S, const Epi& E) {
    const int tid = threadIdx.x, wid = __builtin_amdgcn_readfirstlane(tid >> 6), lane = tid & 63, wr = wid >> 2, wc = wid & 3, fr = lane & 15, fq = lane >> 4;
    const int K = g.K, nt = K / BK;
    unsigned voffA[2], voffB[2];
#pragma unroll
    for (int i = 0; i < 2; ++i) { int R, C; stage_rc(tid * 16 + i * 8192, R, C); const int Rb = Epi::PERM ? ((R & ~31) + perm32(R & 31)) : R;
        const int Ra = AMAP ? (126 * (R >> 6) + 8 * (R & 15) + ((R >> 4) & 3)) : R; voffA[i] = (unsigned)(Ra * K + C) * 2u; voffB[i] = (unsigned)(Rb * K + C) * 2u; }
    const size_t kstep = (size_t)(BK * 2);
    const size_t hstep = (size_t)HALF * K * 2;
    const size_t tstep = 2 * hstep;
    const size_t hstepA = AMAP ? (size_t)4 * K * 2 : hstep;
#define PG8_AOFF(pm) (AMAP ? ((ptrdiff_t)252 * (pm) - 2) * (ptrdiff_t)K * 2 : (ptrdiff_t)((size_t)(pm) * tstep))
    const unsigned ldsw = (unsigned)wid * 1024u;
    const int aoff = lds_byte(wr * 64 + fr, fq * 8), boff = lds_byte(wc * 32 + fr, fq * 8);
#define PG8_SA(b, h) (((b) * 2 + (h)) * HTB)
#define PG8_SB(b, h) ((4 + (b) * 2 + (h)) * HTB)
#define PG8_STAGE(bufoff, gbase, voff) do { _Pragma("unroll") for (int _i = 0; _i < 2; ++_i) \
        __builtin_amdgcn_global_load_lds((const unsigned*)((const char*)(gbase) + (voff)[_i]), (PG8_LAS unsigned*)(lds + (bufoff) + ldsw + _i * 8192), 16, 0, 0); } while (0)
#define PG8_LDA(dst, b, h) do { _Pragma("unroll") for (int m = 0; m < 4; ++m) _Pragma("unroll") for (int k = 0; k < 2; ++k) dst[m][k] = *(const PG8_LAS bf16x8*)(lds + PG8_SA(b, h) + aoff + m * 2048 + k * 1024); } while (0)
#define PG8_LDB(dst, b, h) do { _Pragma("unroll") for (int n = 0; n < 2; ++n) _Pragma("unroll") for (int k = 0; k < 2; ++k) dst[n][k] = *(const PG8_LAS bf16x8*)(lds + PG8_SB(b, h) + boff + n * 2048 + k * 1024); } while (0)
#define PG8_MMA(ai, bj, At, Bt) do { __builtin_amdgcn_s_setprio(1); _Pragma("unroll") for (int m = 0; m < 4; ++m) _Pragma("unroll") for (int n = 0; n < 2; ++n) _Pragma("unroll") for (int k = 0; k < 2; ++k) \
        acc[ai][bj][m][n] = __builtin_amdgcn_mfma_f32_16x16x32_bf16(Bt[n][k], At[m][k], acc[ai][bj][m][n], 0, 0, 0); __builtin_amdgcn_s_setprio(0); } while (0)
#define PG8_WAIT_V(n) asm volatile("s_waitcnt vmcnt(" #n ")" ::: "memory")
#define PG8_WAIT_L(n) asm volatile("s_waitcnt lgkmcnt(" #n ")" ::: "memory")
#define PG8_BAR __builtin_amdgcn_s_barrier()
#define PG8_SCHED __builtin_amdgcn_sched_barrier(0)
    Unit cur, nxt; int ui = 0;
    if (!S.next(0, cur)) return;
    f32x4 acc[2][2][4][2];
#pragma unroll
    for (int a = 0; a < 2; ++a)
#pragma unroll
        for (int b = 0; b < 2; ++b)
#pragma unroll
            for (int m = 0; m < 4; ++m)
#pragma unroll
                for (int n = 0; n < 2; ++n) acc[a][b][m][n] = (f32x4){0.f, 0.f, 0.f, 0.f};
    bf16x8 At[4][2], B0[2][2], B1[2][2];
    const char* cA = (const char*)g.A + PG8_AOFF(cur.pm); const char* cB = (const char*)g.Bt + (size_t)cur.pn * tstep;
    S.a_ready(cur);
    if constexpr (SP2) {
        PG8_STAGE(PG8_SB(0, 0), cB, voffB); PG8_STAGE(PG8_SB(0, 1), cB + hstep, voffB); PG8_STAGE(PG8_SA(0, 0), cA, voffA); PG8_STAGE(PG8_SA(0, 1), cA + hstepA, voffA);
        if (wr == 1) PG8_BAR;
        PG8_WAIT_V(2); PG8_BAR;
        PG8_STAGE(PG8_SB(1, 0), cB + kstep, voffB); PG8_STAGE(PG8_SA(1, 0), cA + kstep, voffA); PG8_STAGE(PG8_SB(1, 1), cB + hstep + kstep, voffB);
        PG8_WAIT_V(6); PG8_BAR;
    } else {
        PG8_STAGE(PG8_SB(0, 0), cB, voffB); PG8_STAGE(PG8_SA(0, 0), cA, voffA); PG8_STAGE(PG8_SB(0, 1), cB + hstep, voffB); PG8_STAGE(PG8_SA(0, 1), cA + hstepA, voffA);
        if (wr == 1) PG8_BAR;
        PG8_WAIT_V(4); PG8_BAR;
        PG8_STAGE(PG8_SB(1, 0), cB + kstep, voffB); PG8_STAGE(PG8_SA(1, 0), cA + kstep, voffA); PG8_STAGE(PG8_SB(1, 1), cB + hstep + kstep, voffB);
        PG8_WAIT_V(6); PG8_BAR;
    }
    for (;;) {
        const bool has_next = S.next(ui + 1, nxt);
        const char* nA = has_next ? (const char*)g.A + PG8_AOFF(nxt.pm) : cA; const char* nB = has_next ? (const char*)g.Bt + (size_t)nxt.pn * tstep : cB;
        for (int t = 0; t < nt; t += 2) {
            const bool last = (t == nt - 2);
            const char* a1 = cA + (size_t)(t + 1) * kstep;
            const char* a2 = last ? nA : cA + (size_t)(t + 2) * kstep; const char* b2 = last ? nB : cB + (size_t)(t + 2) * kstep;
            const char* a3 = a2 + kstep; const char* b3 = b2 + kstep;
            if (last && has_next) S.a_ready(nxt);
            if constexpr (SP2) {
            PG8_LDB(B0, 0, 0); PG8_LDB(B1, 0, 1); PG8_SCHED; PG8_LDA(At, 0, 0); PG8_STAGE(PG8_SA(1, 1), a1 + hstepA, voffA);
            PG8_WAIT_V(8); PG8_WAIT_L(0); PG8_BAR; PG8_MMA(0, 0, At, B0); PG8_MMA(0, 1, At, B1); PG8_BAR; PG8_SCHED;
            PG8_LDA(At, 0, 1); PG8_STAGE(PG8_SB(0, 0), b2, voffB); PG8_STAGE(PG8_SB(0, 1), b2 + hstep, voffB); PG8_STAGE(PG8_SA(0, 0), a2, voffA);
            PG8_WAIT_V(8); PG8_WAIT_L(0); PG8_BAR; PG8_MMA(1, 0, At, B0); PG8_MMA(1, 1, At, B1); PG8_BAR; PG8_SCHED;
            PG8_LDB(B0, 1, 0); PG8_LDB(B1, 1, 1); PG8_SCHED; PG8_LDA(At, 1, 0); PG8_STAGE(PG8_SA(0, 1), a2 + hstepA, voffA);
            PG8_WAIT_V(8); PG8_WAIT_L(0); PG8_BAR; PG8_MMA(0, 0, At, B0); PG8_MMA(0, 1, At, B1); PG8_BAR; PG8_SCHED;
            PG8_LDA(At, 1, 1); PG8_STAGE(PG8_SB(1, 0), b3, voffB); PG8_STAGE(PG8_SB(1, 1), b3 + hstep, voffB); PG8_STAGE(PG8_SA(1, 0), a3, voffA);
            PG8_WAIT_V(8); PG8_WAIT_L(0); PG8_BAR; PG8_MMA(1, 0, At, B0); PG8_MMA(1, 1, At, B1); PG8_BAR; PG8_SCHED;
            } else {
            PG8_LDB(B0, 0, 0); PG8_SCHED; PG8_LDA(At, 0, 0); PG8_STAGE(PG8_SA(1, 1), a1 + hstepA, voffA);
            PG8_WAIT_L(8); PG8_BAR; PG8_WAIT_L(0); PG8_MMA(0, 0, At, B0); PG8_BAR; PG8_SCHED;
            PG8_LDB(B1, 0, 1); PG8_STAGE(PG8_SB(0, 0), b2, voffB);
            PG8_BAR; PG8_WAIT_L(0); PG8_MMA(0, 1, At, B1); PG8_BAR;
            PG8_LDA(At, 0, 1); PG8_STAGE(PG8_SA(0, 0), a2, voffA);
            PG8_BAR; PG8_WAIT_L(0); PG8_MMA(1, 0, At, B0); PG8_BAR; PG8_SCHED;
            PG8_STAGE(PG8_SB(0, 1), b2 + hstep, voffB);
            PG8_WAIT_V(6); PG8_BAR; PG8_MMA(1, 1, At, B1); PG8_BAR;
            PG8_LDB(B0, 1, 0); PG8_SCHED; PG8_LDA(At, 1, 0); PG8_STAGE(PG8_SA(0, 1), a2 + hstepA, voffA);
            PG8_WAIT_L(8); PG8_BAR; PG8_WAIT_L(0); PG8_MMA(0, 0, At, B0); PG8_BAR; PG8_SCHED;
            PG8_LDB(B1, 1, 1); PG8_STAGE(PG8_SB(1, 0), b3, voffB);
            PG8_BAR; PG8_WAIT_L(0); PG8_MMA(0, 1, At, B1); PG8_BAR;
            PG8_LDA(At, 1, 1); PG8_STAGE(PG8_SA(1, 0), a3, voffA);
            PG8_BAR; PG8_WAIT_L(0); PG8_MMA(1, 0, At, B0); PG8_BAR; PG8_SCHED;
            PG8_STAGE(PG8_SB(1, 1), b3 + hstep, voffB);
            PG8_WAIT_V(6); PG8_BAR; PG8_MMA(1, 1, At, B1); PG8_BAR;
            }
        }
        if constexpr (ALIGN_EPI) { if (wr == 0) PG8_BAR; }
        if constexpr (!Epi::AFTER_DRAIN) { E(acc, cur, wr, wc, fr, fq); S.done(cur); }
        if (!has_next) break;
#pragma unroll
        for (int a = 0; a < 2; ++a)
#pragma unroll
            for (int b = 0; b < 2; ++b)
#pragma unroll
                for (int m = 0; m < 4; ++m)
#pragma unroll
                    for (int n = 0; n < 2; ++n) acc[a][b][m][n] = (f32x4){0.f, 0.f, 0.f, 0.f};
        cur = nxt; cA = nA; cB = nB; ++ui;
        if constexpr (ALIGN_EPI) { if (wr == 1) PG8_BAR; }
    }
    PG8_WAIT_V(0);
    if constexpr (!ALIGN_EPI) { if (wr == 0) PG8_BAR; }
    PG8_BAR;
    if constexpr (Epi::AFTER_DRAIN) { E.fused(acc, cur, wr, wc, fr, fq, lds, wid, lane); S.done(cur); }
#undef PG8_SA
#undef PG8_AOFF
#undef PG8_SB
#undef PG8_STAGE
#undef PG8_LDA
#undef PG8_LDB
#undef PG8_MMA
#undef PG8_WAIT_V
#undef PG8_WAIT_L
#undef PG8_BAR
#undef PG8_SCHED
}
}

#ifndef MK_N_LAUNCHES
#define MK_N_LAUNCHES 1
#endif
constexpr int NWAVES = 8;
constexpr int BATCH = 8, T = 4096, D = 1024, M = BATCH * T;
constexpr int NPROJ = 2840, NP = 3072;
constexpr int DFF = 2816, NGU = 2 * DFF;
constexpr int COL_Q = 0, COL_KC = 512, COL_VC = 640, COL_KS = 768, COL_VS = 896, COL_KW = 1024, COL_VW = 1152, COL_G = 1280, COL_BG = 1304, COL_CG = 1816, COL_U = 2328;
constexpr float EPS = 1e-6f;
constexpr float LOG2E = 1.4426950408889634f;

constexpr size_t MiB = 1u << 20;
constexpr size_t WS_CTL = 0;
constexpr size_t WS_WIN = 2 * MiB, WS_WOUT = 8 * MiB, WS_WGU = 10 * MiB, WS_WDN = 21 * MiB;
constexpr size_t WS_WC1K = 27 * MiB, WS_WC1V = 27 * MiB + 512 * 1024;
constexpr size_t WS_KCMP = 28 * MiB, WS_VCMPT = 28 * MiB + 512 * 1024, WS_SSA = 29 * MiB, WS_CB = 29 * MiB + 512 * 1024;
constexpr size_t WS_XN = 32 * MiB, WS_MIX = 96 * MiB, WS_P = 160 * MiB;
constexpr size_t WS_VTS = 352 * MiB, WS_VTW = 360 * MiB, WS_OATT = 368 * MiB;
constexpr size_t WS_ACT = 160 * MiB, WS_END = 400 * MiB;
static_assert(WS_P + (size_t)M * NP * 2 <= WS_VTS && WS_ACT + (size_t)M * DFF * 2 <= WS_END && WS_OATT + (size_t)M * 512 * 2 <= WS_END, "ws map");

constexpr int CW_BAR = 4096;
constexpr size_t CTL_ZERO_BYTES = 65536;
constexpr int RING_BYTES = 131072;
constexpr int BARLDS_OFF = RING_BYTES + 512;
constexpr int LDS_BYTES = 147456;

#define LAS __attribute__((address_space(3)))
typedef unsigned short bf16;
typedef unsigned u32x4 __attribute__((ext_vector_type(4)));
typedef unsigned u32x2 __attribute__((ext_vector_type(2)));
typedef float f32x4 __attribute__((ext_vector_type(4)));
typedef float f32x2 __attribute__((ext_vector_type(2)));
typedef short bf16x8 __attribute__((ext_vector_type(8)));
typedef short s16x4 __attribute__((ext_vector_type(4)));
typedef __bf16 bf16x2_t __attribute__((ext_vector_type(2)));

__device__ __forceinline__ unsigned pk2(float lo, float hi) { f32x2 v = {lo, hi}; bf16x2_t b = __builtin_convertvector(v, bf16x2_t); return __builtin_bit_cast(unsigned, b); }
__device__ __forceinline__ float bf_lo(unsigned u) { return __uint_as_float(u << 16); }
__device__ __forceinline__ float bf_hi(unsigned u) { return __uint_as_float(u & 0xffff0000u); }
__device__ __forceinline__ float bf1(bf16 u) { return __uint_as_float((unsigned)u << 16); }
__device__ __forceinline__ float wave_sum(float v) {
#pragma unroll
    for (int o = 1; o < 64; o <<= 1) v += __shfl_xor(v, o);
    return v;
}
__device__ __forceinline__ float sigmoidf_(float x) { return 1.0f / (1.0f + __expf(-x)); }

struct Args { const float* in[20]; float* out; unsigned char* ws; int ph_lo, ph_hi; };

__device__ __forceinline__ void p0_transpose_item(const float* W, int K, int Nsrc, bf16* WT, int row_off, LAS float* scr, int item, int nblk, int lane) {
    const int kb = item / nblk, nb = item % nblk, k0 = 64 * kb, n0 = 32 * nb;
    const int n = n0 + (lane & 31);
#pragma unroll 8
    for (int i = 0; i < 32; ++i) { const int kk = 2 * i + (lane >> 5); scr[kk * 33 + (lane & 31)] = (n < Nsrc) ? W[(size_t)(k0 + kk) * Nsrc + n] : 0.f; }
    asm volatile("s_waitcnt lgkmcnt(0)" ::: "memory");
    const int c = lane & 7;
#pragma unroll
    for (int j = 0; j < 4; ++j) { const int nn = (lane >> 3) + 8 * j; const LAS float* s = scr + (8 * c) * 33 + nn;
        u32x4 o; o.x = pk2(s[0 * 33], s[1 * 33]); o.y = pk2(s[2 * 33], s[3 * 33]); o.z = pk2(s[4 * 33], s[5 * 33]); o.w = pk2(s[6 * 33], s[7 * 33]);
        *(u32x4*)(WT + (size_t)(row_off + n0 + nn) * K + k0 + 8 * c) = o; }
    asm volatile("s_waitcnt lgkmcnt(0)" ::: "memory");
}
__device__ __forceinline__ void rms_row_bf16(const float* xrow, const float* g, bf16* orow, int lane) {
    const f32x4* xr = (const f32x4*)xrow + lane; const f32x4* gr = (const f32x4*)g + lane;
    f32x4 v[4]; float s = 0.f;
#pragma unroll
    for (int j = 0; j < 4; ++j) { v[j] = xr[64 * j]; s += (v[j].x * v[j].x + v[j].y * v[j].y) + (v[j].z * v[j].z + v[j].w * v[j].w); }
    const float rs = 1.0f / sqrtf(wave_sum(s) * (1.f / D) + EPS);
    u32x2* o8 = (u32x2*)orow + lane;
#pragma unroll
    for (int j = 0; j < 4; ++j) { const f32x4 gg = gr[64 * j]; u32x2 o; o.x = pk2(v[j].x * rs * gg.x, v[j].y * rs * gg.y); o.y = pk2(v[j].z * rs * gg.z, v[j].w * rs * gg.w); o8[64 * j] = o; }
}

__device__ __forceinline__ float gelu_tanh(float x) { const float u = 0.7978845608028654f * (x + 0.044715f * x * x * x); return 0.5f * x * (1.0f + tanhf(u)); }

__device__ __forceinline__ void compress_item(const Args& a, LAS unsigned char* lds, int item, int tid) {
    const int lane = tid & 63, w = __builtin_amdgcn_readfirstlane(tid >> 6), r16 = lane & 15, kq = lane >> 4;
    const int kv = item >> 7, b = (item >> 4) & 7, h = (item >> 3) & 1, ib = item & 7;
    unsigned char* ws = a.ws;
    const bf16* P = (const bf16*)(ws + WS_P);
    const bf16* W1T = (const bf16*)(ws + (kv ? WS_WC1V : WS_WC1K));
    const float* w2 = a.in[kv ? 8 : 5];
    LAS unsigned char* Al = lds;
    LAS float* hid = (LAS float*)(lds + 67584);
    const int col0 = (kv ? COL_VC : COL_KC) + h * 64;
    for (int idx = tid; idx < 528 * 8; idx += 512) {
        const int tau = idx >> 3, c = idx & 7; int tok = 512 * ib + tau; tok = tok < T ? tok : T - 1;
        const u32x4 v = *(const u32x4*)(P + (size_t)(b * T + tok) * NP + col0 + 8 * c);
        *(LAS u32x4*)(Al + tau * 128 + ((c ^ ((tau >> 4) & 7)) << 4)) = v;
    }
    __syncthreads();
    f32x4 acc0 = {0.f, 0.f, 0.f, 0.f}, acc1 = {0.f, 0.f, 0.f, 0.f};
    const bf16* wrow = W1T + (size_t)(16 * w + r16) * 2048 + 8 * kq;
#pragma unroll 8
    for (int s = 0; s < 64; ++s) {
        const bf16x8 af = *(const bf16x8*)(wrow + 32 * s);
        const int l = s >> 1, c = (s & 1) * 4 + kq;
        const int tau0 = 16 * r16 + l, tau1 = tau0 + 256;
        const bf16x8 b0 = *(const LAS bf16x8*)(Al + tau0 * 128 + ((c ^ ((tau0 >> 4) & 7)) << 4));
        const bf16x8 b1 = *(const LAS bf16x8*)(Al + tau1 * 128 + ((c ^ ((tau1 >> 4) & 7)) << 4));
        acc0 = __builtin_amdgcn_mfma_f32_16x16x32_bf16(af, b0, acc0, 0, 0, 0);
        acc1 = __builtin_amdgcn_mfma_f32_16x16x32_bf16(af, b1, acc1, 0, 0, 0);
    }
#pragma unroll
    for (int j = 0; j < 4; ++j) { const int n = 16 * w + 4 * kq + j; const float bs = ((const float*)(ws + WS_CB))[kv * 128 + n];
        hid[r16 * 129 + n] = gelu_tanh(acc0[j] + bs); hid[(16 + r16) * 129 + n] = gelu_tanh(acc1[j] + bs); }
    __syncthreads();
    {
        const int i = tid >> 4, d4 = (tid & 15) * 4; f32x4 o = {0.f, 0.f, 0.f, 0.f};
#pragma unroll 8
        for (int n = 0; n < 128; ++n) { const float hv = hid[i * 129 + n]; const f32x4 wv = *(const f32x4*)(w2 + n * 64 + d4); o += hv * wv; }
        const int ig = 32 * ib + i;
        if (ig == 255) o = (f32x4){0.f, 0.f, 0.f, 0.f};
        if (kv == 0) { bf16* K = (bf16*)(ws + WS_KCMP); u32x2 pk; pk.x = pk2(o.x, o.y); pk.y = pk2(o.z, o.w); *(u32x2*)(K + ((size_t)(b * 2 + h) * 256 + ig) * 64 + d4) = pk; }
        else { bf16* Vt = (bf16*)(ws + WS_VCMPT);
#pragma unroll
            for (int e = 0; e < 4; ++e) Vt[((size_t)(b * 2 + h) * 64 + d4 + e) * 256 + ig] = (bf16)(pk2(o[e], 0.f) & 0xffffu); }
    }
    __syncthreads();
}

__device__ __forceinline__ void vtrans_item(const Args& a, LAS unsigned char* lds, int item, int tid) {
    const int which = item >> 10, b = (item >> 7) & 7, hk = (item >> 6) & 1, tt = item & 63;
    const bf16* P = (const bf16*)(a.ws + WS_P);
    bf16* VT = (bf16*)(a.ws + (which ? WS_VTW : WS_VTS));
    const int r = tid >> 3, c = tid & 7;
    const u32x4 v = *(const u32x4*)(P + (size_t)(b * T + 64 * tt + r) * NP + (which ? COL_VW : COL_VS) + hk * 64 + 8 * c);
    *(LAS u32x4*)(lds + r * 144 + c * 16) = v;
    __syncthreads();
    const int d = tid >> 3;
    unsigned short e[8];
#pragma unroll
    for (int j = 0; j < 8; ++j) e[j] = *(const LAS unsigned short*)(lds + (8 * c + j) * 144 + d * 2);
    u32x4 o; o.x = e[0] | ((unsigned)e[1] << 16); o.y = e[2] | ((unsigned)e[3] << 16); o.z = e[4] | ((unsigned)e[5] << 16); o.w = e[6] | ((unsigned)e[7] << 16);
    *(u32x4*)(VT + ((size_t)(b * 2 + hk) * 64 + d) * T + 64 * tt + 8 * c) = o;
    __syncthreads();
}

__device__ __forceinline__ void conv_row(const Args& a, int m, int lane) {
    const bf16* P = (const bf16*)(a.ws + WS_P); bf16* MIX = (bf16*)(a.ws + WS_MIX);
    const float* cw = a.in[9]; const float* gn = a.in[11];
    const int t = m & (T - 1), ch = 8 * lane;
    const bf16* row = P + (size_t)m * NP;
    float y[8];
#pragma unroll
    for (int e = 0; e < 8; ++e) y[e] = 0.f;
#pragma unroll
    for (int k = 0; k < 3; ++k) {
        const int dt = 2 - k;
        if (t - dt >= 0) {
            const u32x4 cv = *(const u32x4*)(row - (size_t)dt * NP + COL_CG + ch), uv = *(const u32x4*)(row - (size_t)dt * NP + COL_U + ch);
            const f32x4 w0 = *(const f32x4*)(cw + k * 512 + ch), w1 = *(const f32x4*)(cw + k * 512 + ch + 4);
            y[0] += w0.x * bf_lo(cv.x) * bf_lo(uv.x); y[1] += w0.y * bf_hi(cv.x) * bf_hi(uv.x);
            y[2] += w0.z * bf_lo(cv.y) * bf_lo(uv.y); y[3] += w0.w * bf_hi(cv.y) * bf_hi(uv.y);
            y[4] += w1.x * bf_lo(cv.z) * bf_lo(uv.z); y[5] += w1.y * bf_hi(cv.z) * bf_hi(uv.z);
            y[6] += w1.z * bf_lo(cv.w) * bf_lo(uv.w); y[7] += w1.w * bf_hi(cv.w) * bf_hi(uv.w);
        }
    }
    const u32x4 bv = *(const u32x4*)(row + COL_BG + ch);
    y[0] *= bf_lo(bv.x); y[1] *= bf_hi(bv.x); y[2] *= bf_lo(bv.y); y[3] *= bf_hi(bv.y); y[4] *= bf_lo(bv.z); y[5] *= bf_hi(bv.z); y[6] *= bf_lo(bv.w); y[7] *= bf_hi(bv.w);
    float s = 0.f;
#pragma unroll
    for (int e = 0; e < 8; ++e) s += y[e] * y[e];
    const float rs = 1.0f / sqrtf(wave_sum(s) * (1.f / 512.f) + EPS);
    const f32x4 g0 = *(const f32x4*)(gn + ch), g1 = *(const f32x4*)(gn + ch + 4);
    u32x4 o; o.x = pk2(y[0] * rs * g0.x, y[1] * rs * g0.y); o.y = pk2(y[2] * rs * g0.z, y[3] * rs * g0.w); o.z = pk2(y[4] * rs * g1.x, y[5] * rs * g1.y); o.w = pk2(y[6] * rs * g1.z, y[7] * rs * g1.w);
    *(u32x4*)(MIX + (size_t)m * D + 512 + ch) = o;
}

constexpr int AL_K0 = 0, AL_V0 = 18432, AL_IMP = 36864, AL_SELM = 54272, AL_WUN = 54784, AL_CTL = 54848, AL_OUT = 55296;
constexpr int TPITCH = 144;
constexpr int IMPP = 68;

struct TileRegs { u32x4 k, v; };
__device__ __forceinline__ TileRegs tile_load(const bf16* kb, unsigned kp, const bf16* vb, unsigned vp, int tid) {
    int r = tid >> 3, c = tid & 7; TileRegs t;
    asm volatile("" : "+v"(r), "+v"(c));
    const unsigned ko = ((unsigned)r * kp + 8u * (unsigned)c) * 2u, vo = ((unsigned)r * vp + 8u * (unsigned)c) * 2u;
    t.k = *(const u32x4*)((const char*)kb + ko); t.v = *(const u32x4*)((const char*)vb + vo); return t;
}
__device__ __forceinline__ void tile_store(LAS unsigned char* lds, int buf, const TileRegs& t, int tid) {
    const int r = tid >> 3, c = tid & 7;
    *(LAS u32x4*)(lds + AL_K0 + buf * 9216 + r * TPITCH + c * 16) = t.k;
    *(LAS u32x4*)(lds + AL_V0 + buf * 9216 + r * TPITCH + c * 16) = t.v;
}

template <int MODE, bool MASKED>
__device__ __forceinline__ void tile_compute(LAS unsigned char* lds, int buf, int pos0, int t, const bf16x8 (&Qf)[2][2], const float (&sl8)[2], const float (&sl2)[2],
                                             float (&mrow)[2], float (&lrow)[2], f32x4 (&O)[2][4], bool selbit, LAS float* improw, int impj0, int lane) {
    const int r16 = lane & 15, kq = lane >> 4;
    const LAS unsigned char* Kb = lds + AL_K0 + buf * 9216; const LAS unsigned char* Vb = lds + AL_V0 + buf * 9216;
    f32x4 st[2][4];
#pragma unroll
    for (int qb = 0; qb < 2; ++qb)
#pragma unroll
        for (int kb = 0; kb < 4; ++kb) st[qb][kb] = (f32x4){0.f, 0.f, 0.f, 0.f};
#pragma unroll
    for (int kb = 0; kb < 4; ++kb) {
#pragma unroll
        for (int ks = 0; ks < 2; ++ks) { const bf16x8 kf = *(const LAS bf16x8*)(Kb + (16 * kb + r16) * TPITCH + (32 * ks + 8 * kq) * 2);
#pragma unroll
            for (int qb = 0; qb < 2; ++qb) st[qb][kb] = __builtin_amdgcn_mfma_f32_16x16x32_bf16(kf, Qf[qb][ks], st[qb][kb], 0, 0, 0); }
        const float kxf = (float)((MODE <= 1 ? 16 : 1) * (16 * kb + r16));
        u32x4 kw; kw.x = (kq == 0) ? pk2(kxf, 0.f) : 0u; kw.y = 0u; kw.z = 0u; kw.w = 0u; const bf16x8 kx = __builtin_bit_cast(bf16x8, kw);
#pragma unroll
        for (int qb = 0; qb < 2; ++qb) { u32x4 qw; qw.x = (kq == 0) ? pk2(sl8[qb], 0.f) : 0u; qw.y = 0u; qw.z = 0u; qw.w = 0u;
            st[qb][kb] = __builtin_amdgcn_mfma_f32_16x16x32_bf16(kx, __builtin_bit_cast(bf16x8, qw), st[qb][kb], 0, 0, 0); }
    }
    __builtin_amdgcn_sched_barrier(0);
    const float sc = 0.125f * LOG2E;
    const int base = (MODE <= 1) ? (t - 16 * pos0 - 31) : (t - pos0);
    float c0[2];
#pragma unroll
    for (int qb = 0; qb < 2; ++qb) { c0[qb] = -sl2[qb] * (float)base; if (MODE == 2 && !selbit) c0[qb] = -1e30f; }
    float tmax[2] = {-1e30f, -1e30f};
    float mnew[2], alpha[2];
    if (MASKED) {
#pragma unroll
        for (int qb = 0; qb < 2; ++qb)
#pragma unroll
            for (int kb = 0; kb < 4; ++kb) {
                f32x4 s = st[qb][kb] * sc + c0[qb];
#pragma unroll
                for (int j = 0; j < 4; ++j) { const int kidx = 16 * kb + 4 * kq + j; const int dist = base - (MODE <= 1 ? 16 : 1) * kidx;
                    const bool v = (MODE == 3) ? ((unsigned)dist < 512u) : (dist >= 0); s[j] = v ? s[j] : -1e30f; }
                st[qb][kb] = s; tmax[qb] = fmaxf(fmaxf(tmax[qb], fmaxf(s[0], s[1])), fmaxf(s[2], s[3]));
            }
    } else {
#pragma unroll
        for (int qb = 0; qb < 2; ++qb) {
#pragma unroll
            for (int kb = 0; kb < 4; ++kb) tmax[qb] = fmaxf(fmaxf(tmax[qb], fmaxf(st[qb][kb][0], st[qb][kb][1])), fmaxf(st[qb][kb][2], st[qb][kb][3]));
            tmax[qb] = tmax[qb] * sc + c0[qb];
        }
    }
#pragma unroll
    for (int qb = 0; qb < 2; ++qb) {
        if (MODE == 1) { mnew[qb] = mrow[qb]; alpha[qb] = 1.f; }
        else { float tm = tmax[qb]; tm = fmaxf(tm, __shfl_xor(tm, 16)); tm = fmaxf(tm, __shfl_xor(tm, 32)); mnew[qb] = fmaxf(mrow[qb], tm); alpha[qb] = __builtin_amdgcn_exp2f(mrow[qb] - mnew[qb]); mrow[qb] = mnew[qb]; }
    }
#pragma unroll
    for (int qb = 0; qb < 2; ++qb) {
        f32x4 ps = {0.f, 0.f, 0.f, 0.f};
        const float cm = c0[qb] - mnew[qb];
#pragma unroll
        for (int kb = 0; kb < 4; ++kb) { f32x4 p = MASKED ? (st[qb][kb] - mnew[qb]) : (st[qb][kb] * sc + cm);
#pragma unroll
            for (int j = 0; j < 4; ++j) p[j] = __builtin_amdgcn_exp2f(p[j]);
            if (MODE == 1) p = p * lrow[qb];
            st[qb][kb] = p; ps += p; }
        if (MODE != 1) lrow[qb] = lrow[qb] * alpha[qb] + ((ps[0] + ps[1]) + (ps[2] + ps[3]));
    }
    if (MODE == 0) return;
    if (MODE == 1) {
#pragma unroll
        for (int kb = 0; kb < 4; ++kb) {
            float vm = (st[0][kb][0] + st[0][kb][1]) + (st[0][kb][2] + 0.5f * st[0][kb][3]) + (st[1][kb][0] + st[1][kb][1]) + (st[1][kb][2] + 0.5f * st[1][kb][3]);
            float vh = 0.5f * st[0][kb][3] + 0.5f * st[1][kb][3];
            vm += __shfl_xor(vm, 8); vh += __shfl_xor(vh, 8);
            const int jj = impj0 + 4 * kb + kq;
            if ((lane & 8) == 0) { improw[jj] += vm; }
            if ((lane & 8) == 0) { improw[jj + 1] += vh; }
        }
    }
    if (MODE >= 2) {
#pragma unroll
        for (int qb = 0; qb < 2; ++qb)
#pragma unroll
            for (int db = 0; db < 4; ++db) O[qb][db] *= alpha[qb];
    }
    bf16x8 Pf[2][2];
#pragma unroll
    for (int qb = 0; qb < 2; ++qb)
#pragma unroll
        for (int s2 = 0; s2 < 2; ++s2) { u32x4 w; w.x = pk2(st[qb][2 * s2][0], st[qb][2 * s2][1]); w.y = pk2(st[qb][2 * s2][2], st[qb][2 * s2][3]);
            w.z = pk2(st[qb][2 * s2 + 1][0], st[qb][2 * s2 + 1][1]); w.w = pk2(st[qb][2 * s2 + 1][2], st[qb][2 * s2 + 1][3]); Pf[qb][s2] = __builtin_bit_cast(bf16x8, w); }
    __builtin_amdgcn_sched_barrier(0);
#pragma unroll
    for (int db = 0; db < 4; ++db)
#pragma unroll
        for (int s2 = 0; s2 < 2; ++s2) {
            const u32x2 lo = *(const LAS u32x2*)(Vb + (16 * db + r16) * TPITCH + (32 * s2 + 4 * kq) * 2);
            const u32x2 hi = *(const LAS u32x2*)(Vb + (16 * db + r16) * TPITCH + (32 * s2 + 16 + 4 * kq) * 2);
            u32x4 w; w.x = lo.x; w.y = lo.y; w.z = hi.x; w.w = hi.y; const bf16x8 vf = __builtin_bit_cast(bf16x8, w);
#pragma unroll
            for (int qb = 0; qb < 2; ++qb) O[qb][db] = __builtin_amdgcn_mfma_f32_16x16x32_bf16(vf, Pf[qb][s2], O[qb][db], 0, 0, 0);
        }
}

__device__ __forceinline__ void attn_item(const Args& a, LAS unsigned char* lds, int it, int tid) {
    const int lane = tid & 63, w = __builtin_amdgcn_readfirstlane(tid >> 6), r16 = lane & 15, kq = lane >> 4, tql = r16 & 7, gl = r16 >> 3;
    const int c = 63 - (it >> 4), b = (it >> 1) & 7, hk = it & 1;
    unsigned char* ws = a.ws;
    const bf16* P = (const bf16*)(ws + WS_P);
    const bf16* KC = (const bf16*)(ws + WS_KCMP) + (size_t)(b * 2 + hk) * 256 * 64;
    const bf16* VCT = (const bf16*)(ws + WS_VCMPT) + (size_t)(b * 2 + hk) * 64 * 256;
    const bf16* VTS = (const bf16*)(ws + WS_VTS) + (size_t)(b * 2 + hk) * 64 * T;
    const bf16* VTW = (const bf16*)(ws + WS_VTW) + (size_t)(b * 2 + hk) * 64 * T;
    const bf16* PKS = P + (size_t)b * T * NP + COL_KS + hk * 64;
    const bf16* PKW = P + (size_t)b * T * NP + COL_KW + hk * 64;
    const int tq = 8 * w + tql, t = 64 * c + tq; const unsigned R = (unsigned)(b * T + t);
    LAS float* imp = (LAS float*)(lds + AL_IMP); LAS unsigned* selm = (LAS unsigned*)(lds + AL_SELM); LAS unsigned* wunl = (LAS unsigned*)(lds + AL_WUN);
    LAS float* improw = imp + tq * IMPP;

    bf16x8 Qf[2][2]; float sl2[2], sl8[2];
#pragma unroll
    for (int qb = 0; qb < 2; ++qb) { const int hq = hk * 4 + 2 * qb + gl; sl2[qb] = LOG2E * exp2f(-(float)(hq + 1));
        sl8[qb] = exp2f((float)(2 - hq));
#pragma unroll
        for (int ks = 0; ks < 2; ++ks) Qf[qb][ks] = *(const bf16x8*)((const char*)P + (R * NP + COL_Q + hq * 64 + 32 * ks + 8 * kq) * 2u); }
    LAS float* outl = (LAS float*)(lds + AL_OUT) + tid;
#define GATE(qb, br) sigmoidf_(bf1(*(const bf16*)((const char*)P + (R * NP + COL_G + hk * 12 + (2 * (qb) + gl) * 3 + (br)) * 2u)))
    for (int i = lane; i < 8 * IMPP; i += 64) imp[(8 * w) * IMPP + i] = 0.f;

    f32x4 O[2][4];
#pragma unroll
    for (int qb = 0; qb < 2; ++qb)
#pragma unroll
        for (int db = 0; db < 4; ++db) O[qb][db] = (f32x4){0.f, 0.f, 0.f, 0.f};
    float mrow[2] = {-1e25f, -1e25f}, lrow[2] = {0.f, 0.f};
    int buf = 0;
    TileRegs tr;

    const int nct = (4 * c + 3 + 63) >> 6;
    tr = tile_load(KC, 64, VCT, 256, tid);
    for (int ti = 0; ti < nct; ++ti) {
        tile_store(lds, buf, tr, tid); __syncthreads();
        { const int nx = (ti + 1 < nct) ? ti + 1 : 0; tr = tile_load(KC + (size_t)nx * 64 * 64, 64, VCT + nx * 64, 256, tid); }
        if (16 * (64 * ti + 63) + 31 <= 64 * c) tile_compute<0, false>(lds, buf, 64 * ti, t, Qf, sl8, sl2, mrow, lrow, O, true, improw, 0, lane);
        else tile_compute<0, true>(lds, buf, 64 * ti, t, Qf, sl8, sl2, mrow, lrow, O, true, improw, 0, lane);
        buf ^= 1;
    }
#pragma unroll
    for (int qb = 0; qb < 2; ++qb) { float l = lrow[qb]; l += __shfl_xor(l, 16); l += __shfl_xor(l, 32); lrow[qb] = l > 0.f ? 1.0f / l : 0.f; }
    for (int ti = 0; ti < nct; ++ti) {
        tile_store(lds, buf, tr, tid); __syncthreads();
        if (ti + 1 < nct) tr = tile_load(KC + (size_t)(ti + 1) * 64 * 64, 64, VCT + (ti + 1) * 64, 256, tid);
        if (16 * (64 * ti + 63) + 31 <= 64 * c) tile_compute<1, false>(lds, buf, 64 * ti, t, Qf, sl8, sl2, mrow, lrow, O, true, improw, 16 * ti, lane);
        else tile_compute<1, true>(lds, buf, 64 * ti, t, Qf, sl8, sl2, mrow, lrow, O, true, improw, 16 * ti, lane);
        buf ^= 1;
    }
#pragma unroll
    for (int qb = 0; qb < 2; ++qb) { const float g0 = GATE(qb, 0);
#pragma unroll
        for (int db = 0; db < 4; ++db) {
#pragma unroll
            for (int e = 0; e < 4; ++e) outl[((qb * 4 + db) * 4 + e) * 512] = g0 * O[qb][db][e];
            O[qb][db] = (f32x4){0.f, 0.f, 0.f, 0.f}; } }

    unsigned long long wun = 0ull;
    for (int tt = 0; tt < 8; ++tt) {
        LAS unsigned* row = (LAS unsigned*)(imp + (8 * w + tt) * IMPP);
        unsigned key = ((row[lane] & ~63u) + 64u) | (unsigned)(63 - lane);
        if (lane == 0 || lane == c || lane == c - 1) key = 0x7f000000u | (unsigned)(63 - lane);
        if (lane > c) key = (unsigned)(63 - lane);
        row[lane] = key;
        int rank = 0;
#pragma unroll
        for (int i4 = 0; i4 < 16; ++i4) { const u32x4 v = *(const LAS u32x4*)(row + 4 * i4);
#pragma unroll
            for (int e = 0; e < 4; ++e) rank += (v[e] > key) ? 1 : 0; }
        const bool sel = (rank < 16) && (lane <= c);
        const unsigned long long mk = __ballot(sel);
        wun |= mk;
        if (lane == 0) { selm[(8 * w + tt) * 2] = (unsigned)mk; selm[(8 * w + tt) * 2 + 1] = (unsigned)(mk >> 32); }
    }
    if (lane == 0) { wunl[2 * w] = (unsigned)wun; wunl[2 * w + 1] = (unsigned)(wun >> 32); }
    const unsigned long long mysel = (unsigned long long)selm[tq * 2] | ((unsigned long long)selm[tq * 2 + 1] << 32);
    __syncthreads();
    unsigned long long uni = 0ull;
#pragma unroll
    for (int i = 0; i < 8; ++i) uni |= (unsigned long long)wunl[2 * i] | ((unsigned long long)wunl[2 * i + 1] << 32);
    uni = ((unsigned long long)__builtin_amdgcn_readfirstlane((unsigned)(uni >> 32)) << 32) | (unsigned long long)__builtin_amdgcn_readfirstlane((unsigned)uni);

    mrow[0] = mrow[1] = -1e25f; lrow[0] = lrow[1] = 0.f;
    {
        int j = __builtin_ctzll(uni);
        tr = tile_load(PKS + (size_t)(64 * j) * NP, NP, VTS + 64 * j, T, tid);
        while (uni) {
            j = __builtin_ctzll(uni); uni &= uni - 1;
            tile_store(lds, buf, tr, tid); __syncthreads();
            if (uni) { const int jn = __builtin_ctzll(uni); tr = tile_load(PKS + (size_t)(64 * jn) * NP, NP, VTS + 64 * jn, T, tid); }
            if ((wun >> j) & 1ull) { const bool sb = ((mysel >> j) & 1ull) != 0ull;
                if (j < c) tile_compute<2, false>(lds, buf, 64 * j, t, Qf, sl8, sl2, mrow, lrow, O, sb, improw, 0, lane);
                else tile_compute<2, true>(lds, buf, 64 * j, t, Qf, sl8, sl2, mrow, lrow, O, sb, improw, 0, lane); }
            buf ^= 1;
        }
    }
#pragma unroll
    for (int qb = 0; qb < 2; ++qb) { float l = lrow[qb]; l += __shfl_xor(l, 16); l += __shfl_xor(l, 32); const float inv = (l > 0.f ? 1.0f / l : 0.f) * GATE(qb, 1);
#pragma unroll
        for (int db = 0; db < 4; ++db) {
#pragma unroll
            for (int e = 0; e < 4; ++e) outl[((qb * 4 + db) * 4 + e) * 512] += inv * O[qb][db][e];
            O[qb][db] = (f32x4){0.f, 0.f, 0.f, 0.f}; } }

    mrow[0] = mrow[1] = -1e25f; lrow[0] = lrow[1] = 0.f;
    {
        const int j0 = c >= 8 ? c - 8 : 0;
        tr = tile_load(PKW + (size_t)(64 * j0) * NP, NP, VTW + 64 * j0, T, tid);
        for (int j = j0; j <= c; ++j) {
            tile_store(lds, buf, tr, tid); __syncthreads();
            if (j < c) tr = tile_load(PKW + (size_t)(64 * (j + 1)) * NP, NP, VTW + 64 * (j + 1), T, tid);
            if (j < c && j > c - 8) tile_compute<3, false>(lds, buf, 64 * j, t, Qf, sl8, sl2, mrow, lrow, O, true, improw, 0, lane);
            else tile_compute<3, true>(lds, buf, 64 * j, t, Qf, sl8, sl2, mrow, lrow, O, true, improw, 0, lane);
            buf ^= 1;
        }
    }
    float ss = 0.f;
    bf16* OA = (bf16*)(ws + WS_OATT);
#pragma unroll
    for (int qb = 0; qb < 2; ++qb) { float l = lrow[qb]; l += __shfl_xor(l, 16); l += __shfl_xor(l, 32); const float inv = (l > 0.f ? 1.0f / l : 0.f) * GATE(qb, 2);
#pragma unroll
        for (int db = 0; db < 4; ++db) { f32x4 o;
#pragma unroll
            for (int e = 0; e < 4; ++e) o[e] = outl[((qb * 4 + db) * 4 + e) * 512] + inv * O[qb][db][e];
            ss += (o.x * o.x + o.y * o.y) + (o.z * o.z + o.w * o.w);
            u32x2 pk; pk.x = pk2(o.x, o.y); pk.y = pk2(o.z, o.w);
            *(u32x2*)((char*)OA + (R * 512 + hk * 256 + (2 * qb + gl) * 64 + 16 * db + 4 * kq) * 2u) = pk; } }
    ss += __shfl_xor(ss, 8); ss += __shfl_xor(ss, 16); ss += __shfl_xor(ss, 32);
    if (lane < 8) *(float*)(ws + WS_SSA + (R * 2 + hk) * 4u) = ss;
    __syncthreads();
#undef GATE
}


#define RLX_AGENT __ATOMIC_RELAXED, __HIP_MEMORY_SCOPE_AGENT
#define XB_TMO      128
#define XB_XCNT(j)  (256  + 64 * (j))
#define XB_XSUB(j)  (1280 + 64 * (j))
#define XB_XGEN(j)  (2304 + 64 * (j))
#define XB_TOP      3328
#define XB_TOPGEN   3392
#define XCD_BAR_WORDS 3456
#define XB_SPIN_CAP (1u << 18)

__device__ __forceinline__ unsigned xb_ld(unsigned* p)              { return __hip_atomic_load(p, __ATOMIC_RELAXED, __HIP_MEMORY_SCOPE_AGENT); }
__device__ __forceinline__ unsigned xb_add(unsigned* p, unsigned v) { return __hip_atomic_fetch_add(p, v, __ATOMIC_RELAXED, __HIP_MEMORY_SCOPE_AGENT); }
__device__ __forceinline__ unsigned xb_xcc_id() { return (unsigned)__builtin_amdgcn_s_getreg((3 << 11) | 20) & 0xFu; }
#define XB_SPIN(cond, bar) do { unsigned _sp = 0; while (cond) { __builtin_amdgcn_s_sleep(1); \
    if ((++_sp & 255u) == 0u) { if (xb_ld(&(bar)[XB_TMO])) break; if (_sp > XB_SPIN_CAP) { atomicAdd(&(bar)[XB_TMO], 1u); break; } } } } while (0)

struct XcdBarrier {
    unsigned* bar; unsigned x;
    volatile LAS unsigned* st;
};

__device__ __forceinline__ XcdBarrier xcd_barrier_post(unsigned* bar, volatile LAS unsigned* st) {
    XcdBarrier b; b.bar = bar; b.x = xb_xcc_id(); b.st = st;
    if (threadIdx.x == 0) (void)xb_add(&bar[XB_XCNT(b.x)], 1u);
    return b;
}
__device__ __forceinline__ void xcd_barrier_complete(unsigned* bar, unsigned x, unsigned& nloc, unsigned& nx) {
    const unsigned G = gridDim.x * gridDim.y * gridDim.z;
    unsigned sum, cnt, mine, sp = 0u;
    for (;;) {
        sum = 0u; cnt = 0u; mine = 0u;
#pragma unroll
        for (unsigned j = 0; j < 16; ++j) { const unsigned c = xb_ld(&bar[XB_XCNT(j)]); sum += c; cnt += (c > 0u) ? 1u : 0u; mine = (j == x) ? c : mine; }
        if (sum == G) break;
        __builtin_amdgcn_s_sleep(1);
        if ((++sp & 255u) == 0u) { if (xb_ld(&bar[XB_TMO])) break; if (sp > XB_SPIN_CAP) { atomicAdd(&bar[XB_TMO], 1u); break; } }
    }
    nloc = mine > 0u ? mine : 1u; nx = cnt > 0u ? cnt : 1u;
}

__device__ __forceinline__ void xcd_barrier(const XcdBarrier& b) {
    asm volatile("s_waitcnt vmcnt(0)" ::: "memory");
    __syncthreads();
    if (threadIdx.x == 0) {
        unsigned* bar = b.bar;
        __builtin_amdgcn_s_waitcnt(0);
        unsigned nloc = b.st[0], nx = b.st[1];
        if (nloc == 0u) { xcd_barrier_complete(bar, b.x, nloc, nx); b.st[0] = nloc; b.st[1] = nx; }
        const unsigned old = xb_add(&bar[XB_XSUB(b.x)], 1u);
        const unsigned gen = old / nloc;
        if (old + 1u == (gen + 1u) * nloc) {
            __builtin_amdgcn_fence(__ATOMIC_RELEASE, "agent");
            asm volatile("s_waitcnt vmcnt(0)" ::: "memory");
            const unsigned og = xb_add(&bar[XB_TOP], 1u);
            const unsigned tg = og / nx;
            if (og + 1u == (tg + 1u) * nx) xb_add(&bar[XB_TOPGEN], 1u);
            else XB_SPIN(xb_ld(&bar[XB_TOPGEN]) == tg, bar);
            __builtin_amdgcn_fence(__ATOMIC_ACQUIRE, "agent");
            xb_add(&bar[XB_XGEN(b.x)], 1u);
            asm volatile("s_waitcnt vmcnt(0)" ::: "memory");
        } else {
            XB_SPIN(xb_ld(&bar[XB_XGEN(b.x)]) == gen, bar);
            __builtin_amdgcn_fence(__ATOMIC_ACQUIRE, "agent");
            asm volatile("s_waitcnt vmcnt(0)" ::: "memory");
        }
    }
    __syncthreads();
}

constexpr int NPHASE = 11;
__global__ void __launch_bounds__(NWAVES * 64, 2) hymba_fwd(Args args) {
    extern __shared__ __attribute__((aligned(16))) unsigned char lds_raw[];
    LAS unsigned char* lds = (LAS unsigned char*)lds_raw;
    cg::grid_group grid = cg::this_grid();
    const int tid = threadIdx.x, lane = tid & 63, wave = __builtin_amdgcn_readfirstlane(tid >> 6);
    const int G = gridDim.x, bx = blockIdx.x;
    const int gw = bx * NWAVES + wave, NGW = G * NWAVES;
    unsigned char* ws = args.ws;
    const int lo = args.ph_lo, hi = args.ph_hi;
#define IN(k) (lo <= (k) && (k) < hi)
    if (tid < 16) ((LAS unsigned*)(lds + BARLDS_OFF))[tid] = 0u;
    __syncthreads();
    XcdBarrier bar = xcd_barrier_post((unsigned*)(ws + WS_CTL) + CW_BAR, (volatile LAS unsigned*)(lds + BARLDS_OFF));
#define SEAM(k) do { if (IN(k) && IN((k) + 1)) { if ((k) == 0) grid.sync(); else xcd_barrier(bar); } } while (0)

    if (IN(0)) {
        LAS float* scr = (LAS float*)(lds + wave * 16384);
        constexpr int I_IN = 16 * 96, I_OUT = 16 * 32, I_G = 16 * 88, I_DN = 44 * 32, I_C1 = 32 * 4;
        constexpr int NITEMS = I_IN + I_OUT + 2 * I_G + I_DN + 2 * I_C1;
        for (int it = gw; it < NITEMS; it += NGW) {
            int r = it;
            if (r < I_IN) { p0_transpose_item(args.in[2], D, NPROJ, (bf16*)(ws + WS_WIN), 0, scr, r, 96, lane); continue; } r -= I_IN;
            if (r < I_OUT) { p0_transpose_item(args.in[12], D, D, (bf16*)(ws + WS_WOUT), 0, scr, r, 32, lane); continue; } r -= I_OUT;
            if (r < I_G) { const int n0 = 32 * (r % 88); p0_transpose_item(args.in[14], D, DFF, (bf16*)(ws + WS_WGU), 256 * (n0 >> 7) + (n0 & 127) - n0, scr, r, 88, lane); continue; } r -= I_G;
            if (r < I_G) { const int n0 = 32 * (r % 88); p0_transpose_item(args.in[15], D, DFF, (bf16*)(ws + WS_WGU), 256 * (n0 >> 7) + 128 + (n0 & 127) - n0, scr, r, 88, lane); continue; } r -= I_G;
            if (r < I_DN) { p0_transpose_item(args.in[18], DFF, D, (bf16*)(ws + WS_WDN), 0, scr, r, 32, lane); continue; } r -= I_DN;
            if (r < I_C1) { p0_transpose_item(args.in[4], 2048, 128, (bf16*)(ws + WS_WC1K), 0, scr, r, 4, lane); continue; } r -= I_C1;
            p0_transpose_item(args.in[7], 2048, 128, (bf16*)(ws + WS_WC1V), 0, scr, r, 4, lane);
        }
        if (gw < 256) {
            const int kv = gw >> 7, n = gw & 127; const float* pos = args.in[kv ? 6 : 3]; const float* w1 = args.in[kv ? 7 : 4]; float s = 0.f;
#pragma unroll 8
            for (int k = lane; k < 2048; k += 64) s += pos[k] * w1[(size_t)k * 128 + n];
            s = wave_sum(s);
            if (lane == 0) ((float*)(ws + WS_CB))[gw] = s;
        }
        for (int m = gw; m < M; m += NGW) rms_row_bf16(args.in[0] + (size_t)m * D, args.in[1], (bf16*)(ws + WS_XN) + (size_t)m * D, lane);
    }
    SEAM(0);
    if (IN(1)) {
        pg8::Gemm g{(const pg8::bf16_t*)(ws + WS_XN), (const pg8::bf16_t*)(ws + WS_WIN), M, NP, D}; pg8::StaticOrder S; S.init(M, NP, G, bx);
        pg8::EpiBf16 E{(pg8::bf16_t*)(ws + WS_P), NP, 0, 0};
        pg8::gemm_phase<pg8::EpiBf16, pg8::StaticOrder, true, true>(lds, g, S, E);
    }
    SEAM(1);
    if (IN(2)) {
        for (int it = bx; it < 256; it += G) compress_item(args, lds, it, tid);
        for (int it = bx; it < 2048; it += G) vtrans_item(args, lds, it, tid);
        for (int m = gw; m < M; m += NGW) conv_row(args, m, lane);
    }
    SEAM(2);
    if (IN(3)) {
        LAS int* ctl = (LAS int*)(lds + AL_CTL);
        for (;;) {
            if (tid == 0) ctl[0] = (int)atomicAdd((unsigned*)(ws + WS_CTL), 1u);
            __syncthreads();
            const int it = ctl[0];
            if (it >= 1024) break;
            attn_item(args, lds, it, tid);
        }
    }
    SEAM(3);
    if (IN(4)) {
        const bf16* OA = (const bf16*)(ws + WS_OATT); const float* ssa = (const float*)(ws + WS_SSA); bf16* MIX = (bf16*)(ws + WS_MIX); const float* gn = args.in[10];
        for (int m = gw; m < M; m += NGW) {
            const float rs = 1.0f / sqrtf((ssa[2 * m] + ssa[2 * m + 1]) * (1.f / 512.f) + EPS);
            const int ch = 8 * lane; const u32x4 v = *(const u32x4*)(OA + (size_t)m * 512 + ch);
            const f32x4 g0 = *(const f32x4*)(gn + ch), g1 = *(const f32x4*)(gn + ch + 4);
            u32x4 o; o.x = pk2(bf_lo(v.x) * rs * g0.x, bf_hi(v.x) * rs * g0.y); o.y = pk2(bf_lo(v.y) * rs * g0.z, bf_hi(v.y) * rs * g0.w);
            o.z = pk2(bf_lo(v.z) * rs * g1.x, bf_hi(v.z) * rs * g1.y); o.w = pk2(bf_lo(v.w) * rs * g1.z, bf_hi(v.w) * rs * g1.w);
            *(u32x4*)(MIX + (size_t)m * D + ch) = o;
        }
    }
    SEAM(4);
    if (IN(5)) {
        pg8::Gemm g{(const pg8::bf16_t*)(ws + WS_MIX), (const pg8::bf16_t*)(ws + WS_WOUT), M, D, D}; pg8::StaticOrder S; S.init(M, D, G, bx);
        pg8::EpiResF32 E{args.in[0], args.out, D};
        pg8::gemm_phase<pg8::EpiResF32, pg8::StaticOrder, true, true>(lds, g, S, E);
    }
    SEAM(5);
    if (IN(6)) {
        for (int m = gw; m < M; m += NGW) rms_row_bf16(args.out + (size_t)m * D, args.in[13], (bf16*)(ws + WS_XN) + (size_t)m * D, lane);
    }
    SEAM(6);
    if (IN(7)) {
        constexpr int NMT = (M + 251) / 252;
        pg8::Gemm g{(const pg8::bf16_t*)(ws + WS_XN), (const pg8::bf16_t*)(ws + WS_WGU), NMT * 256, NGU, D}; pg8::StaticOrder S; S.init(NMT * 256, NGU, G, bx);
        pg8::EpiFfn E{(pg8::bf16_t*)(ws + WS_ACT), args.in[16], args.in[17], M, DFF, T};
        pg8::gemm_phase<pg8::EpiFfn, pg8::StaticOrder, true, true, true>(lds, g, S, E);
    }
    SEAM(7);
    if (IN(9)) {
        pg8::Gemm g{(const pg8::bf16_t*)(ws + WS_ACT), (const pg8::bf16_t*)(ws + WS_WDN), M, D, DFF}; pg8::StaticOrder S; S.init(M, D, G, bx);
        pg8::EpiResF32 E{args.out, args.out, D};
        pg8::gemm_phase<pg8::EpiResF32, pg8::StaticOrder, true, true>(lds, g, S, E);
    }
    SEAM(9);
    if (IN(10)) {
        const float* gn = args.in[19];
        for (int m = gw; m < M; m += NGW) {
            f32x4* xr = (f32x4*)(args.out + (size_t)m * D) + lane; const f32x4* gr = (const f32x4*)gn + lane;
            f32x4 v[4]; float s = 0.f;
#pragma unroll
            for (int j = 0; j < 4; ++j) { v[j] = xr[64 * j]; s += (v[j].x * v[j].x + v[j].y * v[j].y) + (v[j].z * v[j].z + v[j].w * v[j].w); }
            const float rs = 1.0f / sqrtf(wave_sum(s) * (1.f / D) + EPS);
#pragma unroll
            for (int j = 0; j < 4; ++j) xr[64 * j] = v[j] * rs * gr[64 * j];
        }
    }
#undef IN
#undef SEAM
}

extern "C" void kernel_launch(void* const* d_in, const int* in_sizes, int n_in, void* d_out, int out_size, void* d_ws, size_t ws_size, hipStream_t stream) {
    static int grid = 0;
    if (grid == 0) {
        if (n_in != 20 || in_sizes[0] != M * D || out_size != M * D || ws_size < WS_END) { fprintf(stderr, "kernel_launch: unexpected sizes n_in %d in0 %d out %d ws %zu\n", n_in, n_in > 0 ? in_sizes[0] : -1, out_size, ws_size); grid = -1; return; }
        int dev = 0, cus = 0, per_cu = 0;
        hipGetDevice(&dev); hipDeviceGetAttribute(&cus, hipDeviceAttributeMultiprocessorCount, dev);
        if (hipFuncSetAttribute((const void*)hymba_fwd, hipFuncAttributeMaxDynamicSharedMemorySize, LDS_BYTES) != hipSuccess) { fprintf(stderr, "kernel_launch: hipFuncSetAttribute failed\n"); grid = -1; return; }
        if (hipOccupancyMaxActiveBlocksPerMultiprocessor(&per_cu, (const void*)hymba_fwd, NWAVES * 64, LDS_BYTES) != hipSuccess || per_cu < 1) { fprintf(stderr, "kernel_launch: occupancy query says %d\n", per_cu); per_cu = 1; }
        (void)hipGetLastError();
        grid = cus * per_cu;
    }
    if (grid < 0) return;
    if (hipMemsetAsync((char*)d_ws + WS_CTL, 0, CTL_ZERO_BYTES, stream) != hipSuccess) { fprintf(stderr, "kernel_launch: memset failed\n"); return; }
    Args a{};
    for (int i = 0; i < 20; ++i) a.in[i] = (const float*)d_in[i];
    a.out = (float*)d_out; a.ws = (unsigned char*)d_ws;
#if MK_N_LAUNCHES == 1
    a.ph_lo = 0; a.ph_hi = NPHASE;
    void* kargs[] = {&a};
    hipError_t e = hipLaunchCooperativeKernel((const void*)hymba_fwd, dim3(grid), dim3(NWAVES * 64), kargs, LDS_BYTES, stream);
    if (e != hipSuccess) fprintf(stderr, "cooperative launch failed: %s (grid %d)\n", hipGetErrorString(e), grid);
#else
    for (int p = 0; p < NPHASE; ++p) { a.ph_lo = p; a.ph_hi = p + 1; hipLaunchKernelGGL(hymba_fwd, dim3(grid), dim3(NWAVES * 64), LDS_BYTES, stream, a); }
#endif
}
```

```cpp
#include <hip/hip_runtime.h>
#include <hip/hip_cooperative_groups.h>
#include <cstdio>
#include <cstdint>
namespace cg = cooperative_groups;
namespace pg8 {
#define PG8_LAS __attribute__((address_space(3)))
typedef unsigned short bf16_t;
typedef short bf16x8 __attribute__((ext_vector_type(8)));
typedef float f32x4 __attribute__((ext_vector_type(4)));
typedef unsigned u32x4 __attribute__((ext_vector_type(4)));
constexpr int BM = 256, BK = 64, HALF = 128, HTB = HALF * BK * 2  , STAGE_BYTES = 8 * HTB, NXCD = 8, WGM = 8;

__host__ __device__ __forceinline__ int lds_byte(int r, int c) { const int st = (r >> 4) * 2 + (c >> 5), rr = r & 15, cc = c & 31, ob = rr * 64 + cc * 2; return st * 1024 + (ob ^ (((ob >> 9) & 1) << 5)); }
__host__ __device__ __forceinline__ void stage_rc(int b, int& R, int& C) { const int st = b / 1024, sb = b % 1024, swz = sb ^ (((sb >> 9) & 1) << 5); R = (st >> 1) * 16 + swz / 64; C = (st & 1) * 32 + (swz % 64) / 2; }
__host__ __device__ __forceinline__ int perm32(int rho) { const int n = rho >> 4, i = rho & 15; return 8 * (i >> 2) + 4 * n + (i & 3); }

struct Unit { int pm, pn; };
struct Gemm { const bf16_t* A; const bf16_t* Bt; int M, N, K; };

struct StaticOrder {
    int nM, nN, nwg, G, c;
    __host__ __device__ void init(int M, int N, int G_, int c_) { nM = M / BM; nN = N / BM; nwg = nM * nN; G = G_; c = c_; }
    __host__ __device__ bool next(int i, Unit& u) const {
        const long L = (long)i * G + c; if (L >= nwg) return false;
        int wgid = (int)L; { const int q = nwg / NXCD, r = nwg % NXCD, xcd = wgid % NXCD, off = wgid / NXCD; wgid = (xcd < r ? xcd * (q + 1) : r * (q + 1) + (xcd - r) * q) + off; }
        const int nig = WGM * nN, gid = wgid / nig, fm = gid * WGM, gsz = (nM - fm) < WGM ? (nM - fm) : WGM;
        u.pm = fm + ((wgid % nig) % gsz); u.pn = (wgid % nig) / gsz; return true;
    }
    __device__ __forceinline__ void a_ready(const Unit&) const {}
    __device__ __forceinline__ void done(const Unit&) const {}
};

__device__ __forceinline__ unsigned cvt_pk_bf16(float lo, float hi) { unsigned r; asm volatile("v_cvt_pk_bf16_f32 %0, %1, %2" : "=v"(r) : "v"(lo), "v"(hi)); return r; }

struct EpiBf16 {
    static constexpr bool PERM = true, AFTER_DRAIN = false, HAS_MID = false;
    bf16_t* O; int ldc; int split_cols; size_t split_stride;
    __device__ __forceinline__ void operator()(const f32x4 (&acc)[2][2][4][2], const Unit& u, int wr, int wc, int fr, int fq) const {
        const int row0 = u.pm * BM + wr * 64 + fr; int colt = u.pn * BM; bf16_t* base = O;
        if (split_cols) { const int t = colt / split_cols; base += (size_t)t * split_stride; colt -= t * split_cols; }
        const int col0 = colt + wc * 32 + 8 * fq;
#pragma unroll
        for (int ai = 0; ai < 2; ++ai)
#pragma unroll
            for (int m = 0; m < 4; ++m) { bf16_t* rowp = base + (size_t)(row0 + ai * HALF + m * 16) * ldc + col0;
#pragma unroll
                for (int bj = 0; bj < 2; ++bj) { const f32x4 v0 = acc[ai][bj][m][0], v1 = acc[ai][bj][m][1];
                    u32x4 w; w.x = cvt_pk_bf16(v0[0], v0[1]); w.y = cvt_pk_bf16(v0[2], v0[3]); w.z = cvt_pk_bf16(v1[0], v1[1]); w.w = cvt_pk_bf16(v1[2], v1[3]);
                    *(u32x4*)(rowp + bj * HALF) = w; } }
    }
};
struct EpiResF32 {
    static constexpr bool PERM = false, AFTER_DRAIN = false, HAS_MID = false;
    const float* base; float* out; int ldc;
    __device__ __forceinline__ void operator()(const f32x4 (&acc)[2][2][4][2], const Unit& u, int wr, int wc, int fr, int fq) const {
        const int col0 = u.pn * BM + wc * 32 + 4 * fq;
#pragma unroll
        for (int ai = 0; ai < 2; ++ai)
#pragma unroll
            for (int m = 0; m < 4; ++m) { const size_t off = (size_t)(u.pm * BM + ai * HALF + wr * 64 + m * 16 + fr) * ldc + col0;
#pragma unroll
                for (int bj = 0; bj < 2; ++bj)
#pragma unroll
                    for (int n = 0; n < 2; ++n) { const f32x4 bs = *(const f32x4*)(base + off + bj * HALF + n * 16); *(f32x4*)(out + off + bj * HALF + n * 16) = bs + acc[ai][bj][m][n]; } }
    }
};


struct EpiResF32Mid {
    static constexpr bool PERM = false, AFTER_DRAIN = false, HAS_MID = true; static constexpr int MID_T = 8;
    const float* base; float* out; int ldc; const float* ssq; float inv_n, eps;
    __device__ __forceinline__ void mid(f32x4 (&acc)[2][2][4][2], const Unit& u, int wr, int wc, int fr, int fq) const {
#pragma unroll
        for (int ai = 0; ai < 2; ++ai)
#pragma unroll
            for (int m = 0; m < 4; ++m) { const int row = u.pm * BM + ai * HALF + wr * 64 + m * 16 + fr; const float s = ssq[2 * row] + ssq[2 * row + 1]; const float rs = 1.0f / sqrtf(s * inv_n + eps);
#pragma unroll
                for (int bj = 0; bj < 2; ++bj)
#pragma unroll
                    for (int n = 0; n < 2; ++n) acc[ai][bj][m][n] *= rs; }
    }
    __device__ __forceinline__ void operator()(const f32x4 (&acc)[2][2][4][2], const Unit& u, int wr, int wc, int fr, int fq) const {
        const int col0 = u.pn * BM + wc * 32 + 4 * fq;
#pragma unroll
        for (int ai = 0; ai < 2; ++ai)
#pragma unroll
            for (int m = 0; m < 4; ++m) { const size_t off = (size_t)(u.pm * BM + ai * HALF + wr * 64 + m * 16 + fr) * ldc + col0;
#pragma unroll
                for (int bj = 0; bj < 2; ++bj)
#pragma unroll
                    for (int n = 0; n < 2; ++n) { const f32x4 bs = *(const f32x4*)(base + off + bj * HALF + n * 16); *(f32x4*)(out + off + bj * HALF + n * 16) = bs + acc[ai][bj][m][n]; } }
    }
};

struct EpiFfn {
    static constexpr bool PERM = true, AFTER_DRAIN = false, HAS_MID = false;
    bf16_t* ACT; const float* cw; const float* cb; int Mrows; int DFFc; int Tseq;
    __device__ __forceinline__ void operator()(const f32x4 (&acc)[2][2][4][2], const Unit& u, int wr, int wc, int fr, int fq) const {
        const int ch0 = u.pn * 128 + wc * 32 + 8 * fq;
        const int rbase = 252 * u.pm - 2 + 126 * wr + 8 * fr;
        f32x4 w0[2], w1[2], w2[2], bb[2];
#pragma unroll
        for (int n = 0; n < 2; ++n) { w0[n] = *(const f32x4*)(cw + ch0 + 4 * n); w1[n] = *(const f32x4*)(cw + DFFc + ch0 + 4 * n); w2[n] = *(const f32x4*)(cw + 2 * DFFc + ch0 + 4 * n); bb[n] = *(const f32x4*)(cb + ch0 + 4 * n); }
        float p6[2][4], p7[2][4];
#pragma unroll
        for (int n = 0; n < 2; ++n)
#pragma unroll
            for (int i = 0; i < 4; ++i) { p7[n][i] = __shfl_up(acc[1][0][3][n][i], 1, 16); p6[n][i] = __shfl_up(acc[1][0][2][n][i], 1, 16); }
#pragma unroll
        for (int k = 0; k < 8; ++k) {
            const int r = rbase + k, tk = r & (Tseq - 1);
            const bool ok = (8 * fr + k >= 2) && (r < Mrows);
            float o[2][4];
#pragma unroll
            for (int n = 0; n < 2; ++n)
#pragma unroll
                for (int i = 0; i < 4; ++i) {
                    const float gk = acc[k >> 2][0][k & 3][n][i];
                    float gm1 = (k >= 1) ? acc[(k >= 1 ? k - 1 : 0) >> 2][0][(k >= 1 ? k - 1 : 0) & 3][n][i] : p7[n][i];
                    float gm2 = (k >= 2) ? acc[(k >= 2 ? k - 2 : 0) >> 2][0][(k >= 2 ? k - 2 : 0) & 3][n][i] : (k == 1 ? p7[n][i] : p6[n][i]);
                    gm1 = tk >= 1 ? gm1 : 0.f; gm2 = tk >= 2 ? gm2 : 0.f;
                    const float gt = w0[n][i] * gm2 + w1[n][i] * gm1 + w2[n][i] * gk + bb[n][i];
                    o[n][i] = gt * (1.0f / (1.0f + __expf(-gt))) * acc[k >> 2][1][k & 3][n][i];
                }
            u32x4 w; w.x = cvt_pk_bf16(o[0][0], o[0][1]); w.y = cvt_pk_bf16(o[0][2], o[0][3]); w.z = cvt_pk_bf16(o[1][0], o[1][1]); w.w = cvt_pk_bf16(o[1][2], o[1][3]);
            if (ok) *(u32x4*)(ACT + (size_t)r * DFFc + ch0) = w;
        }
    }
};

template <class Epi, class Sched, bool ALIGN_EPI = false, bool SP2 = false, bool AMAP = false>
__device__ __forceinline__ void gemm_phase(PG8_LAS unsigned char* lds, const Gemm g, const Sched& S, const Epi& E) {
    const int tid = threadIdx.x, wid = __builtin_amdgcn_readfirstlane(tid >> 6), lane = tid & 63, wr = wid >> 2, wc = wid & 3, fr = lane & 15, fq = lane >> 4;
    const int K = g.K, nt = K / BK;
    unsigned voffA[2], voffB[2];
#pragma unroll
    for (int i = 0; i < 2; ++i) { int R, C; stage_rc(tid * 16 + i * 8192, R, C); const int Rb = Epi::PERM ? ((R & ~31) + perm32(R & 31)) : R;
        const int Ra = AMAP ? (126 * (R >> 6) + 8 * (R & 15) + ((R >> 4) & 3)) : R; voffA[i] = (unsigned)(Ra * K + C) * 2u; voffB[i] = (unsigned)(Rb * K + C) * 2u; }
    const size_t kstep = (size_t)(BK * 2);
    const size_t hstep = (size_t)HALF * K * 2;
    const size_t tstep = 2 * hstep;
    const size_t hstepA = AMAP ? (size_t)4 * K * 2 : hstep;
#define PG8_AOFF(pm) (AMAP ? ((ptrdiff_t)252 * (pm) - 2) * (ptrdiff_t)K * 2 : (ptrdiff_t)((size_t)(pm) * tstep))
    const unsigned ldsw = (unsigned)wid * 1024u;
    const int aoff = lds_byte(wr * 64 + fr, fq * 8), boff = lds_byte(wc * 32 + fr, fq * 8);
#define PG8_SA(b, h) (((b) * 2 + (h)) * HTB)
#define PG8_SB(b, h) ((4 + (b) * 2 + (h)) * HTB)
#define PG8_STAGE(bufoff, gbase, voff) do { _Pragma("unroll") for (int _i = 0; _i < 2; ++_i) \
        __builtin_amdgcn_global_load_lds((const unsigned*)((const char*)(gbase) + (voff)[_i]), (PG8_LAS unsigned*)(lds + (bufoff) + ldsw + _i * 8192), 16, 0, 0); } while (0)
#define PG8_LDA(dst, b, h) do { _Pragma("unroll") for (int m = 0; m < 4; ++m) _Pragma("unroll") for (int k = 0; k < 2; ++k) dst[m][k] = *(const PG8_LAS bf16x8*)(lds + PG8_SA(b, h) + aoff + m * 2048 + k * 1024); } while (0)
#define PG8_LDB(dst, b, h) do { _Pragma("unroll") for (int n = 0; n < 2; ++n) _Pragma("unroll") for (int k = 0; k < 2; ++k) dst[n][k] = *(const PG8_LAS bf16x8*)(lds + PG8_SB(b, h) + boff + n * 2048 + k * 1024); } while (0)
#define PG8_MMA(ai, bj, At, Bt) do { __builtin_amdgcn_s_setprio(1); _Pragma("unroll") for (int m = 0; m < 4; ++m) _Pragma("unroll") for (int n = 0; n < 2; ++n) _Pragma("unroll") for (int k = 0; k < 2; ++k) \
        acc[ai][bj][m][n] = __builtin_amdgcn_mfma_f32_16x16x32_bf16(Bt[n][k], At[m][k], acc[ai][bj][m][n], 0, 0, 0); __builtin_amdgcn_s_setprio(0); } while (0)
#define PG8_WAIT_V(n) asm volatile("s_waitcnt vmcnt(" #n ")" ::: "memory")
#define PG8_WAIT_L(n) asm volatile("s_waitcnt lgkmcnt(" #n ")" ::: "memory")
#define PG8_BAR __builtin_amdgcn_s_barrier()
#define PG8_SCHED __builtin_amdgcn_sched_barrier(0)
    Unit cur, nxt; int ui = 0;
    if (!S.next(0, cur)) return;
    f32x4 acc[2][2][4][2];
#pragma unroll
    for (int a = 0; a < 2; ++a)
#pragma unroll
        for (int b = 0; b < 2; ++b)
#pragma unroll
            for (int m = 0; m < 4; ++m)
#pragma unroll
                for (int n = 0; n < 2; ++n) acc[a][b][m][n] = (f32x4){0.f, 0.f, 0.f, 0.f};
    bf16x8 At[4][2], B0[2][2], B1[2][2];
    const char* cA = (const char*)g.A + PG8_AOFF(cur.pm); const char* cB = (const char*)g.Bt + (size_t)cur.pn * tstep;
    S.a_ready(cur);
    if constexpr (SP2) {
        PG8_STAGE(PG8_SB(0, 0), cB, voffB); PG8_STAGE(PG8_SB(0, 1), cB + hstep, voffB); PG8_STAGE(PG8_SA(0, 0), cA, voffA); PG8_STAGE(PG8_SA(0, 1), cA + hstepA, voffA);
        if (wr == 1) PG8_BAR;
        PG8_WAIT_V(2); PG8_BAR;
        PG8_STAGE(PG8_SB(1, 0), cB + kstep, voffB); PG8_STAGE(PG8_SA(1, 0), cA + kstep, voffA); PG8_STAGE(PG8_SB(1, 1), cB + hstep + kstep, voffB);
        PG8_WAIT_V(6); PG8_BAR;
    } else {
        PG8_STAGE(PG8_SB(0, 0), cB, voffB); PG8_STAGE(PG8_SA(0, 0), cA, voffA); PG8_STAGE(PG8_SB(0, 1), cB + hstep, voffB); PG8_STAGE(PG8_SA(0, 1), cA + hstepA, voffA);
        if (wr == 1) PG8_BAR;
        PG8_WAIT_V(4); PG8_BAR;
        PG8_STAGE(PG8_SB(1, 0), cB + kstep, voffB); PG8_STAGE(PG8_SA(1, 0), cA + kstep, voffA); PG8_STAGE(PG8_SB(1, 1), cB + hstep + kstep, voffB);
        PG8_WAIT_V(6); PG8_BAR;
    }
    for (;;) {
        const bool has_next = S.next(ui + 1, nxt);
        const char* nA = has_next ? (const char*)g.A + PG8_AOFF(nxt.pm) : cA; const char* nB = has_next ? (const char*)g.Bt + (size_t)nxt.pn * tstep : cB;
        for (int t = 0; t < nt; t += 2) {
            const bool last = (t == nt - 2);
            const char* a1 = cA + (size_t)(t + 1) * kstep;
            const char* a2 = last ? nA : cA + (size_t)(t + 2) * kstep; const char* b2 = last ? nB : cB + (size_t)(t + 2) * kstep;
            const char* a3 = a2 + kstep; const char* b3 = b2 + kstep;
            if (last && has_next) S.a_ready(nxt);
            if constexpr (Epi::HAS_MID) { if (t == Epi::MID_T) E.mid(acc, cur, wr, wc, fr, fq); }
            if constexpr (SP2) {
            PG8_LDB(B0, 0, 0); PG8_LDB(B1, 0, 1); PG8_SCHED; PG8_LDA(At, 0, 0); PG8_STAGE(PG8_SA(1, 1), a1 + hstepA, voffA);
            PG8_WAIT_V(8); PG8_WAIT_L(0); PG8_BAR; PG8_MMA(0, 0, At, B0); PG8_MMA(0, 1, At, B1); PG8_BAR; PG8_SCHED;
            PG8_LDA(At, 0, 1); PG8_STAGE(PG8_SB(0, 0), b2, voffB); PG8_STAGE(PG8_SB(0, 1), b2 + hstep, voffB); PG8_STAGE(PG8_SA(0, 0), a2, voffA);
            PG8_WAIT_V(8); PG8_WAIT_L(0); PG8_BAR; PG8_MMA(1, 0, At, B0); PG8_MMA(1, 1, At, B1); PG8_BAR; PG8_SCHED;
            PG8_LDB(B0, 1, 0); PG8_LDB(B1, 1, 1); PG8_SCHED; PG8_LDA(At, 1, 0); PG8_STAGE(PG8_SA(0, 1), a2 + hstepA, voffA);
            PG8_WAIT_V(8); PG8_WAIT_L(0); PG8_BAR; PG8_MMA(0, 0, At, B0); PG8_MMA(0, 1, At, B1); PG8_BAR; PG8_SCHED;
            PG8_LDA(At, 1, 1); PG8_STAGE(PG8_SB(1, 0), b3, voffB); PG8_STAGE(PG8_SB(1, 1), b3 + hstep, voffB); PG8_STAGE(PG8_SA(1, 0), a3, voffA);
            PG8_WAIT_V(8); PG8_WAIT_L(0); PG8_BAR; PG8_MMA(1, 0, At, B0); PG8_MMA(1, 1, At, B1); PG8_BAR; PG8_SCHED;
            } else {
            PG8_LDB(B0, 0, 0); PG8_SCHED; PG8_LDA(At, 0, 0); PG8_STAGE(PG8_SA(1, 1), a1 + hstepA, voffA);
            PG8_WAIT_L(8); PG8_BAR; PG8_WAIT_L(0); PG8_MMA(0, 0, At, B0); PG8_BAR; PG8_SCHED;
            PG8_LDB(B1, 0, 1); PG8_STAGE(PG8_SB(0, 0), b2, voffB);
            PG8_BAR; PG8_WAIT_L(0); PG8_MMA(0, 1, At, B1); PG8_BAR;
            PG8_LDA(At, 0, 1); PG8_STAGE(PG8_SA(0, 0), a2, voffA);
            PG8_BAR; PG8_WAIT_L(0); PG8_MMA(1, 0, At, B0); PG8_BAR; PG8_SCHED;
            PG8_STAGE(PG8_SB(0, 1), b2 + hstep, voffB);
            PG8_WAIT_V(6); PG8_BAR; PG8_MMA(1, 1, At, B1); PG8_BAR;
            PG8_LDB(B0, 1, 0); PG8_SCHED; PG8_LDA(At, 1, 0); PG8_STAGE(PG8_SA(0, 1), a2 + hstepA, voffA);
            PG8_WAIT_L(8); PG8_BAR; PG8_WAIT_L(0); PG8_MMA(0, 0, At, B0); PG8_BAR; PG8_SCHED;
            PG8_LDB(B1, 1, 1); PG8_STAGE(PG8_SB(1, 0), b3, voffB);
            PG8_BAR; PG8_WAIT_L(0); PG8_MMA(0, 1, At, B1); PG8_BAR;
            PG8_LDA(At, 1, 1); PG8_STAGE(PG8_SA(1, 0), a3, voffA);
            PG8_BAR; PG8_WAIT_L(0); PG8_MMA(1, 0, At, B0); PG8_BAR; PG8_SCHED;
            PG8_STAGE(PG8_SB(1, 1), b3 + hstep, voffB);
            PG8_WAIT_V(6); PG8_BAR; PG8_MMA(1, 1, At, B1); PG8_BAR;
            }
        }
        if constexpr (ALIGN_EPI) { if (wr == 0) PG8_BAR; }
        if constexpr (!Epi::AFTER_DRAIN) { E(acc, cur, wr, wc, fr, fq); S.done(cur); }
        if (!has_next) break;
#pragma unroll
        for (int a = 0; a < 2; ++a)
#pragma unroll
            for (int b = 0; b < 2; ++b)
#pragma unroll
                for (int m = 0; m < 4; ++m)
#pragma unroll
                    for (int n = 0; n < 2; ++n) acc[a][b][m][n] = (f32x4){0.f, 0.f, 0.f, 0.f};
        cur = nxt; cA = nA; cB = nB; ++ui;
        if constexpr (ALIGN_EPI) { if (wr == 1) PG8_BAR; }
    }
    PG8_WAIT_V(0);
    if constexpr (!ALIGN_EPI) { if (wr == 0) PG8_BAR; }
    PG8_BAR;
    if constexpr (Epi::AFTER_DRAIN) { E.fused(acc, cur, wr, wc, fr, fq, lds, wid, lane); S.done(cur); }
#undef PG8_SA
#undef PG8_AOFF
#undef PG8_SB
#undef PG8_STAGE
#undef PG8_LDA
#undef PG8_LDB
#undef PG8_MMA
#undef PG8_WAIT_V
#undef PG8_WAIT_L
#undef PG8_BAR
#undef PG8_SCHED
}
}

#ifndef MK_N_LAUNCHES
#define MK_N_LAUNCHES 1
#endif
constexpr int NWAVES = 8;
constexpr int BATCH = 8, T = 4096, D = 1024, M = BATCH * T;
constexpr int NPROJ = 2840, NP = 3072;
constexpr int DFF = 2816, NGU = 2 * DFF;
constexpr int COL_Q = 0, COL_KC = 512, COL_VC = 640, COL_KS = 768, COL_VS = 896, COL_KW = 1024, COL_VW = 1152, COL_G = 1280, COL_BG = 1304, COL_CG = 1816, COL_U = 2328;
constexpr float EPS = 1e-6f;
constexpr float LOG2E = 1.4426950408889634f;

constexpr size_t MiB = 1u << 20;
constexpr size_t WS_CTL = 0;
constexpr size_t WS_WIN = 2 * MiB, WS_WOUT = 8 * MiB, WS_WGU = 10 * MiB, WS_WDN = 21 * MiB;
constexpr size_t WS_WC1K = 27 * MiB, WS_WC1V = 27 * MiB + 512 * 1024;
constexpr size_t WS_KCMP = 28 * MiB, WS_VCMPT = 28 * MiB + 512 * 1024, WS_SSA = 29 * MiB, WS_CB = 29 * MiB + 512 * 1024;
constexpr size_t WS_XN = 32 * MiB, WS_MIX = 96 * MiB, WS_P = 160 * MiB;
constexpr size_t WS_VTS = 352 * MiB, WS_VTW = 360 * MiB, WS_OATT = 368 * MiB;
constexpr size_t WS_ACT = 160 * MiB, WS_END = 400 * MiB;
static_assert(WS_P + (size_t)M * NP * 2 <= WS_VTS && WS_ACT + (size_t)M * DFF * 2 <= WS_END && WS_OATT + (size_t)M * 512 * 2 <= WS_END, "ws map");

constexpr int CW_BAR = 4096;
constexpr size_t CTL_ZERO_BYTES = 65536;
constexpr int RING_BYTES = 131072;
constexpr int BARLDS_OFF = RING_BYTES + 512;
constexpr int LDS_BYTES = 147456;

#define LAS __attribute__((address_space(3)))
typedef unsigned short bf16;
typedef unsigned u32x4 __attribute__((ext_vector_type(4)));
typedef unsigned u32x2 __attribute__((ext_vector_type(2)));
typedef float f32x4 __attribute__((ext_vector_type(4)));
typedef float f32x2 __attribute__((ext_vector_type(2)));
typedef short bf16x8 __attribute__((ext_vector_type(8)));
typedef short s16x4 __attribute__((ext_vector_type(4)));
typedef __bf16 bf16x2_t __attribute__((ext_vector_type(2)));

__device__ __forceinline__ unsigned pk2(float lo, float hi) { f32x2 v = {lo, hi}; bf16x2_t b = __builtin_convertvector(v, bf16x2_t); return __builtin_bit_cast(unsigned, b); }
__device__ __forceinline__ float bf_lo(unsigned u) { return __uint_as_float(u << 16); }
__device__ __forceinline__ float bf_hi(unsigned u) { return __uint_as_float(u & 0xffff0000u); }
__device__ __forceinline__ float bf1(bf16 u) { return __uint_as_float((unsigned)u << 16); }
__device__ __forceinline__ float wave_sum(float v) {
#pragma unroll
    for (int o = 1; o < 64; o <<= 1) v += __shfl_xor(v, o);
    return v;
}
__device__ __forceinline__ float sigmoidf_(float x) { return 1.0f / (1.0f + __expf(-x)); }

struct Args { const float* in[20]; float* out; unsigned char* ws; int ph_lo, ph_hi; };

__device__ __forceinline__ void p0_transpose_item(const float* W, int K, int Nsrc, bf16* WT, int row_off, LAS float* scr, int item, int nblk, int lane, const float* kscale = nullptr, int kscale_n = 0) {
    const int kb = item / nblk, nb = item % nblk, k0 = 64 * kb, n0 = 32 * nb;
    const int n = n0 + (lane & 31);
#pragma unroll 8
    for (int i = 0; i < 32; ++i) { const int kk = 2 * i + (lane >> 5); float v = (n < Nsrc) ? W[(size_t)(k0 + kk) * Nsrc + n] : 0.f; if (kscale && k0 + kk < kscale_n) v *= kscale[k0 + kk]; scr[kk * 33 + (lane & 31)] = v; }
    asm volatile("s_waitcnt lgkmcnt(0)" ::: "memory");
    const int c = lane & 7;
#pragma unroll
    for (int j = 0; j < 4; ++j) { const int nn = (lane >> 3) + 8 * j; const LAS float* s = scr + (8 * c) * 33 + nn;
        u32x4 o; o.x = pk2(s[0 * 33], s[1 * 33]); o.y = pk2(s[2 * 33], s[3 * 33]); o.z = pk2(s[4 * 33], s[5 * 33]); o.w = pk2(s[6 * 33], s[7 * 33]);
        *(u32x4*)(WT + (size_t)(row_off + n0 + nn) * K + k0 + 8 * c) = o; }
    asm volatile("s_waitcnt lgkmcnt(0)" ::: "memory");
}
__device__ __forceinline__ void rms_row_bf16(const float* xrow, const float* g, bf16* orow, int lane) {
    const f32x4* xr = (const f32x4*)xrow + lane; const f32x4* gr = (const f32x4*)g + lane;
    f32x4 v[4]; float s = 0.f;
#pragma unroll
    for (int j = 0; j < 4; ++j) { v[j] = xr[64 * j]; s += (v[j].x * v[j].x + v[j].y * v[j].y) + (v[j].z * v[j].z + v[j].w * v[j].w); }
    const float rs = 1.0f / sqrtf(wave_sum(s) * (1.f / D) + EPS);
    u32x2* o8 = (u32x2*)orow + lane;
#pragma unroll
    for (int j = 0; j < 4; ++j) { const f32x4 gg = gr[64 * j]; u32x2 o; o.x = pk2(v[j].x * rs * gg.x, v[j].y * rs * gg.y); o.y = pk2(v[j].z * rs * gg.z, v[j].w * rs * gg.w); o8[64 * j] = o; }
}

__device__ __forceinline__ void rms_row2_bf16(const float* x0, const float* x1, const float* g, bf16* o0, bf16* o1, int lane) {
    const f32x4* xr0 = (const f32x4*)x0 + lane; const f32x4* xr1 = (const f32x4*)x1 + lane; const f32x4* gr = (const f32x4*)g + lane;
    f32x4 v[4], u[4]; float s = 0.f, q = 0.f;
#pragma unroll
    for (int j = 0; j < 4; ++j) { v[j] = xr0[64 * j]; u[j] = xr1[64 * j]; }
#pragma unroll
    for (int j = 0; j < 4; ++j) { s += (v[j].x * v[j].x + v[j].y * v[j].y) + (v[j].z * v[j].z + v[j].w * v[j].w); q += (u[j].x * u[j].x + u[j].y * u[j].y) + (u[j].z * u[j].z + u[j].w * u[j].w); }
    const float rs = 1.0f / sqrtf(wave_sum(s) * (1.f / D) + EPS), rq = 1.0f / sqrtf(wave_sum(q) * (1.f / D) + EPS);
    u32x2* p0 = (u32x2*)o0 + lane; u32x2* p1 = (u32x2*)o1 + lane;
#pragma unroll
    for (int j = 0; j < 4; ++j) { const f32x4 gg = gr[64 * j]; u32x2 o; o.x = pk2(v[j].x * rs * gg.x, v[j].y * rs * gg.y); o.y = pk2(v[j].z * rs * gg.z, v[j].w * rs * gg.w); p0[64 * j] = o;
        o.x = pk2(u[j].x * rq * gg.x, u[j].y * rq * gg.y); o.y = pk2(u[j].z * rq * gg.z, u[j].w * rq * gg.w); p1[64 * j] = o; }
}

__device__ __forceinline__ float gelu_tanh(float x) { const float u = 0.7978845608028654f * (x + 0.044715f * x * x * x); return 0.5f * x * (1.0f + tanhf(u)); }

__device__ __forceinline__ void compress_item(const Args& a, LAS unsigned char* lds, int item, int tid) {
    const int lane = tid & 63, w = __builtin_amdgcn_readfirstlane(tid >> 6), r16 = lane & 15, kq = lane >> 4;
    const int kv = item >> 7, b = (item >> 4) & 7, h = (item >> 3) & 1, ib = item & 7;
    unsigned char* ws = a.ws;
    const bf16* P = (const bf16*)(ws + WS_P);
    const bf16* W1T = (const bf16*)(ws + (kv ? WS_WC1V : WS_WC1K));
    const float* w2 = a.in[kv ? 8 : 5];
    LAS unsigned char* Al = lds;
    LAS float* hid = (LAS float*)(lds + 67584);
    const int col0 = (kv ? COL_VC : COL_KC) + h * 64;
    for (int idx = tid; idx < 528 * 8; idx += 512) {
        const int tau = idx >> 3, c = idx & 7; int tok = 512 * ib + tau; tok = tok < T ? tok : T - 1;
        const u32x4 v = *(const u32x4*)(P + (size_t)(b * T + tok) * NP + col0 + 8 * c);
        *(LAS u32x4*)(Al + tau * 128 + ((c ^ ((tau >> 4) & 7)) << 4)) = v;
    }
    __syncthreads();
    f32x4 acc0 = {0.f, 0.f, 0.f, 0.f}, acc1 = {0.f, 0.f, 0.f, 0.f};
    const bf16* wrow = W1T + (size_t)(16 * w + r16) * 2048 + 8 * kq;
#pragma unroll 8
    for (int s = 0; s < 64; ++s) {
        const bf16x8 af = *(const bf16x8*)(wrow + 32 * s);
        const int l = s >> 1, c = (s & 1) * 4 + kq;
        const int tau0 = 16 * r16 + l, tau1 = tau0 + 256;
        const bf16x8 b0 = *(const LAS bf16x8*)(Al + tau0 * 128 + ((c ^ ((tau0 >> 4) & 7)) << 4));
        const bf16x8 b1 = *(const LAS bf16x8*)(Al + tau1 * 128 + ((c ^ ((tau1 >> 4) & 7)) << 4));
        acc0 = __builtin_amdgcn_mfma_f32_16x16x32_bf16(af, b0, acc0, 0, 0, 0);
        acc1 = __builtin_amdgcn_mfma_f32_16x16x32_bf16(af, b1, acc1, 0, 0, 0);
    }
#pragma unroll
    for (int j = 0; j < 4; ++j) { const int n = 16 * w + 4 * kq + j; const float bs = ((const float*)(ws + WS_CB))[kv * 128 + n];
        hid[r16 * 129 + n] = gelu_tanh(acc0[j] + bs); hid[(16 + r16) * 129 + n] = gelu_tanh(acc1[j] + bs); }
    __syncthreads();
    {
        const int i = tid >> 4, d4 = (tid & 15) * 4; f32x4 o = {0.f, 0.f, 0.f, 0.f};
#pragma unroll 8
        for (int n = 0; n < 128; ++n) { const float hv = hid[i * 129 + n]; const f32x4 wv = *(const f32x4*)(w2 + n * 64 + d4); o += hv * wv; }
        const int ig = 32 * ib + i;
        if (ig == 255) o = (f32x4){0.f, 0.f, 0.f, 0.f};
        if (kv == 0) { bf16* K = (bf16*)(ws + WS_KCMP); u32x2 pk; pk.x = pk2(o.x, o.y); pk.y = pk2(o.z, o.w); *(u32x2*)(K + ((size_t)(b * 2 + h) * 256 + ig) * 64 + d4) = pk; }
        else { bf16* Vt = (bf16*)(ws + WS_VCMPT);
#pragma unroll
            for (int e = 0; e < 4; ++e) Vt[((size_t)(b * 2 + h) * 64 + d4 + e) * 256 + ig] = (bf16)(pk2(o[e], 0.f) & 0xffffu); }
    }
    __syncthreads();
}

__device__ __forceinline__ void vtrans_item(const Args& a, LAS unsigned char* lds, int item, int tid) {
    const int which = item >> 10, b = (item >> 7) & 7, hk = (item >> 6) & 1, tt = item & 63;
    const bf16* P = (const bf16*)(a.ws + WS_P);
    bf16* VT = (bf16*)(a.ws + (which ? WS_VTW : WS_VTS));
    const int r = tid >> 3, c = tid & 7;
    const u32x4 v = *(const u32x4*)(P + (size_t)(b * T + 64 * tt + r) * NP + (which ? COL_VW : COL_VS) + hk * 64 + 8 * c);
    *(LAS u32x4*)(lds + r * 144 + c * 16) = v;
    __syncthreads();
    const int d = tid >> 3;
    unsigned short e[8];
#pragma unroll
    for (int j = 0; j < 8; ++j) e[j] = *(const LAS unsigned short*)(lds + (8 * c + j) * 144 + d * 2);
    u32x4 o; o.x = e[0] | ((unsigned)e[1] << 16); o.y = e[2] | ((unsigned)e[3] << 16); o.z = e[4] | ((unsigned)e[5] << 16); o.w = e[6] | ((unsigned)e[7] << 16);
    *(u32x4*)(VT + ((size_t)(b * 2 + hk) * 64 + d) * T + 64 * tt + 8 * c) = o;
    __syncthreads();
}

__device__ __forceinline__ void conv_row(const Args& a, int m, int lane) {
    const bf16* P = (const bf16*)(a.ws + WS_P); bf16* MIX = (bf16*)(a.ws + WS_MIX);
    const float* cw = a.in[9]; const float* gn = a.in[11];
    const int t = m & (T - 1), ch = 8 * lane;
    const bf16* row = P + (size_t)m * NP;
    float y[8];
#pragma unroll
    for (int e = 0; e < 8; ++e) y[e] = 0.f;
#pragma unroll
    for (int k = 0; k < 3; ++k) {
        const int dt = 2 - k;
        if (t - dt >= 0) {
            const u32x4 cv = *(const u32x4*)(row - (size_t)dt * NP + COL_CG + ch), uv = *(const u32x4*)(row - (size_t)dt * NP + COL_U + ch);
            const f32x4 w0 = *(const f32x4*)(cw + k * 512 + ch), w1 = *(const f32x4*)(cw + k * 512 + ch + 4);
            y[0] += w0.x * bf_lo(cv.x) * bf_lo(uv.x); y[1] += w0.y * bf_hi(cv.x) * bf_hi(uv.x);
            y[2] += w0.z * bf_lo(cv.y) * bf_lo(uv.y); y[3] += w0.w * bf_hi(cv.y) * bf_hi(uv.y);
            y[4] += w1.x * bf_lo(cv.z) * bf_lo(uv.z); y[5] += w1.y * bf_hi(cv.z) * bf_hi(uv.z);
            y[6] += w1.z * bf_lo(cv.w) * bf_lo(uv.w); y[7] += w1.w * bf_hi(cv.w) * bf_hi(uv.w);
        }
    }
    const u32x4 bv = *(const u32x4*)(row + COL_BG + ch);
    y[0] *= bf_lo(bv.x); y[1] *= bf_hi(bv.x); y[2] *= bf_lo(bv.y); y[3] *= bf_hi(bv.y); y[4] *= bf_lo(bv.z); y[5] *= bf_hi(bv.z); y[6] *= bf_lo(bv.w); y[7] *= bf_hi(bv.w);
    float s = 0.f;
#pragma unroll
    for (int e = 0; e < 8; ++e) s += y[e] * y[e];
    const float rs = 1.0f / sqrtf(wave_sum(s) * (1.f / 512.f) + EPS);
    const f32x4 g0 = *(const f32x4*)(gn + ch), g1 = *(const f32x4*)(gn + ch + 4);
    u32x4 o; o.x = pk2(y[0] * rs * g0.x, y[1] * rs * g0.y); o.y = pk2(y[2] * rs * g0.z, y[3] * rs * g0.w); o.z = pk2(y[4] * rs * g1.x, y[5] * rs * g1.y); o.w = pk2(y[6] * rs * g1.z, y[7] * rs * g1.w);
    *(u32x4*)(MIX + (size_t)m * D + 512 + ch) = o;
}

constexpr int AL_K0 = 0, AL_V0 = 18432, AL_IMP = 36864, AL_SELM = 54272, AL_WUN = 54784, AL_CTL = 54848, AL_OUT = 55296;
constexpr int TPITCH = 144;
constexpr int IMPP = 68;

struct TileRegs { u32x4 k, v; };
__device__ __forceinline__ TileRegs tile_load(const bf16* kb, unsigned kp, const bf16* vb, unsigned vp, int tid) {
    int r = tid >> 3, c = tid & 7; TileRegs t;
    asm volatile("" : "+v"(r), "+v"(c));
    const unsigned ko = ((unsigned)r * kp + 8u * (unsigned)c) * 2u, vo = ((unsigned)r * vp + 8u * (unsigned)c) * 2u;
    t.k = *(const u32x4*)((const char*)kb + ko); t.v = *(const u32x4*)((const char*)vb + vo); return t;
}
__device__ __forceinline__ void tile_store(LAS unsigned char* lds, int buf, const TileRegs& t, int tid) {
    const int r = tid >> 3, c = tid & 7;
    *(LAS u32x4*)(lds + AL_K0 + buf * 9216 + r * TPITCH + c * 16) = t.k;
    *(LAS u32x4*)(lds + AL_V0 + buf * 9216 + r * TPITCH + c * 16) = t.v;
}

template <int MODE, bool MASKED>
__device__ __forceinline__ void tile_compute(LAS unsigned char* lds, int buf, int pos0, int t, const bf16x8 (&Qf)[2][2], const float (&sl8)[2], const float (&sl2)[2],
                                             float (&mrow)[2], float (&lrow)[2], f32x4 (&O)[2][4], bool selbit, LAS float* improw, int impj0, int lane) {
    const int r16 = lane & 15, kq = lane >> 4;
    const LAS unsigned char* Kb = lds + AL_K0 + buf * 9216; const LAS unsigned char* Vb = lds + AL_V0 + buf * 9216;
    f32x4 st[2][4];
#pragma unroll
    for (int qb = 0; qb < 2; ++qb)
#pragma unroll
        for (int kb = 0; kb < 4; ++kb) st[qb][kb] = (f32x4){0.f, 0.f, 0.f, 0.f};
#pragma unroll
    for (int kb = 0; kb < 4; ++kb) {
#pragma unroll
        for (int ks = 0; ks < 2; ++ks) { const bf16x8 kf = *(const LAS bf16x8*)(Kb + (16 * kb + r16) * TPITCH + (32 * ks + 8 * kq) * 2);
#pragma unroll
            for (int qb = 0; qb < 2; ++qb) st[qb][kb] = __builtin_amdgcn_mfma_f32_16x16x32_bf16(kf, Qf[qb][ks], st[qb][kb], 0, 0, 0); }
        const float kxf = (float)((MODE <= 1 ? 16 : 1) * (16 * kb + r16));
        u32x4 kw; kw.x = (kq == 0) ? pk2(kxf, 0.f) : 0u; kw.y = 0u; kw.z = 0u; kw.w = 0u; const bf16x8 kx = __builtin_bit_cast(bf16x8, kw);
#pragma unroll
        for (int qb = 0; qb < 2; ++qb) { u32x4 qw; qw.x = (kq == 0) ? pk2(sl8[qb], 0.f) : 0u; qw.y = 0u; qw.z = 0u; qw.w = 0u;
            st[qb][kb] = __builtin_amdgcn_mfma_f32_16x16x32_bf16(kx, __builtin_bit_cast(bf16x8, qw), st[qb][kb], 0, 0, 0); }
    }
    __builtin_amdgcn_sched_barrier(0);
    const float sc = 0.125f * LOG2E;
    const int base = (MODE <= 1) ? (t - 16 * pos0 - 31) : (t - pos0);
    float c0[2];
#pragma unroll
    for (int qb = 0; qb < 2; ++qb) { c0[qb] = -sl2[qb] * (float)base; if (MODE == 2 && !selbit) c0[qb] = -1e30f; }
    float tmax[2] = {-1e30f, -1e30f};
    float mnew[2], alpha[2];
    if (MASKED) {
#pragma unroll
        for (int qb = 0; qb < 2; ++qb)
#pragma unroll
            for (int kb = 0; kb < 4; ++kb) {
                f32x4 s = st[qb][kb] * sc + c0[qb];
#pragma unroll
                for (int j = 0; j < 4; ++j) { const int kidx = 16 * kb + 4 * kq + j; const int dist = base - (MODE <= 1 ? 16 : 1) * kidx;
                    const bool v = (MODE == 3) ? ((unsigned)dist < 512u) : (dist >= 0); s[j] = v ? s[j] : -1e30f; }
                st[qb][kb] = s; tmax[qb] = fmaxf(fmaxf(tmax[qb], fmaxf(s[0], s[1])), fmaxf(s[2], s[3]));
            }
    } else {
#pragma unroll
        for (int qb = 0; qb < 2; ++qb) {
#pragma unroll
            for (int kb = 0; kb < 4; ++kb) tmax[qb] = fmaxf(fmaxf(tmax[qb], fmaxf(st[qb][kb][0], st[qb][kb][1])), fmaxf(st[qb][kb][2], st[qb][kb][3]));
            tmax[qb] = tmax[qb] * sc + c0[qb];
        }
    }
#pragma unroll
    for (int qb = 0; qb < 2; ++qb) {
        if (MODE == 1) { mnew[qb] = mrow[qb]; alpha[qb] = 1.f; }
        else { float tm = tmax[qb]; tm = fmaxf(tm, __shfl_xor(tm, 16)); tm = fmaxf(tm, __shfl_xor(tm, 32)); mnew[qb] = fmaxf(mrow[qb], tm); alpha[qb] = __builtin_amdgcn_exp2f(mrow[qb] - mnew[qb]); mrow[qb] = mnew[qb]; }
    }
#pragma unroll
    for (int qb = 0; qb < 2; ++qb) {
        f32x4 ps = {0.f, 0.f, 0.f, 0.f};
        const float cm = c0[qb] - mnew[qb];
#pragma unroll
        for (int kb = 0; kb < 4; ++kb) { f32x4 p = MASKED ? (st[qb][kb] - mnew[qb]) : (st[qb][kb] * sc + cm);
#pragma unroll
            for (int j = 0; j < 4; ++j) p[j] = __builtin_amdgcn_exp2f(p[j]);
            if (MODE == 1) p = p * lrow[qb];
            st[qb][kb] = p; ps += p; }
        if (MODE != 1) lrow[qb] = lrow[qb] * alpha[qb] + ((ps[0] + ps[1]) + (ps[2] + ps[3]));
    }
    if (MODE == 0) return;
    if (MODE == 1) {
#pragma unroll
        for (int kb = 0; kb < 4; ++kb) {
            float vm = (st[0][kb][0] + st[0][kb][1]) + (st[0][kb][2] + 0.5f * st[0][kb][3]) + (st[1][kb][0] + st[1][kb][1]) + (st[1][kb][2] + 0.5f * st[1][kb][3]);
            float vh = 0.5f * st[0][kb][3] + 0.5f * st[1][kb][3];
            vm += __shfl_xor(vm, 8); vh += __shfl_xor(vh, 8);
            const int jj = impj0 + 4 * kb + kq;
            if ((lane & 8) == 0) { improw[jj] += vm; }
            if ((lane & 8) == 0) { improw[jj + 1] += vh; }
        }
    }
    if (MODE >= 2) {
#pragma unroll
        for (int qb = 0; qb < 2; ++qb)
#pragma unroll
            for (int db = 0; db < 4; ++db) O[qb][db] *= alpha[qb];
    }
    bf16x8 Pf[2][2];
#pragma unroll
    for (int qb = 0; qb < 2; ++qb)
#pragma unroll
        for (int s2 = 0; s2 < 2; ++s2) { u32x4 w; w.x = pk2(st[qb][2 * s2][0], st[qb][2 * s2][1]); w.y = pk2(st[qb][2 * s2][2], st[qb][2 * s2][3]);
            w.z = pk2(st[qb][2 * s2 + 1][0], st[qb][2 * s2 + 1][1]); w.w = pk2(st[qb][2 * s2 + 1][2], st[qb][2 * s2 + 1][3]); Pf[qb][s2] = __builtin_bit_cast(bf16x8, w); }
    __builtin_amdgcn_sched_barrier(0);
#pragma unroll
    for (int db = 0; db < 4; ++db)
#pragma unroll
        for (int s2 = 0; s2 < 2; ++s2) {
            const u32x2 lo = *(const LAS u32x2*)(Vb + (16 * db + r16) * TPITCH + (32 * s2 + 4 * kq) * 2);
            const u32x2 hi = *(const LAS u32x2*)(Vb + (16 * db + r16) * TPITCH + (32 * s2 + 16 + 4 * kq) * 2);
            u32x4 w; w.x = lo.x; w.y = lo.y; w.z = hi.x; w.w = hi.y; const bf16x8 vf = __builtin_bit_cast(bf16x8, w);
#pragma unroll
            for (int qb = 0; qb < 2; ++qb) O[qb][db] = __builtin_amdgcn_mfma_f32_16x16x32_bf16(vf, Pf[qb][s2], O[qb][db], 0, 0, 0);
        }
}

__device__ __forceinline__ void attn_item(const Args& a, LAS unsigned char* lds, int it, int tid) {
    const int lane = tid & 63, w = __builtin_amdgcn_readfirstlane(tid >> 6), r16 = lane & 15, kq = lane >> 4, tql = r16 & 7, gl = r16 >> 3;
    const int c = 63 - (it >> 4), b = (it >> 1) & 7, hk = it & 1;
    unsigned char* ws = a.ws;
    const bf16* P = (const bf16*)(ws + WS_P);
    const bf16* KC = (const bf16*)(ws + WS_KCMP) + (size_t)(b * 2 + hk) * 256 * 64;
    const bf16* VCT = (const bf16*)(ws + WS_VCMPT) + (size_t)(b * 2 + hk) * 64 * 256;
    const bf16* VTS = (const bf16*)(ws + WS_VTS) + (size_t)(b * 2 + hk) * 64 * T;
    const bf16* VTW = (const bf16*)(ws + WS_VTW) + (size_t)(b * 2 + hk) * 64 * T;
    const bf16* PKS = P + (size_t)b * T * NP + COL_KS + hk * 64;
    const bf16* PKW = P + (size_t)b * T * NP + COL_KW + hk * 64;
    const int tq = 8 * w + tql, t = 64 * c + tq; const unsigned R = (unsigned)(b * T + t);
    LAS float* imp = (LAS float*)(lds + AL_IMP); LAS unsigned* selm = (LAS unsigned*)(lds + AL_SELM); LAS unsigned* wunl = (LAS unsigned*)(lds + AL_WUN);
    LAS float* improw = imp + tq * IMPP;

    bf16x8 Qf[2][2]; float sl2[2], sl8[2];
#pragma unroll
    for (int qb = 0; qb < 2; ++qb) { const int hq = hk * 4 + 2 * qb + gl; sl2[qb] = LOG2E * exp2f(-(float)(hq + 1));
        sl8[qb] = exp2f((float)(2 - hq));
#pragma unroll
        for (int ks = 0; ks < 2; ++ks) Qf[qb][ks] = *(const bf16x8*)((const char*)P + (R * NP + COL_Q + hq * 64 + 32 * ks + 8 * kq) * 2u); }
    LAS float* outl = (LAS float*)(lds + AL_OUT) + tid;
#define GATE(qb, br) sigmoidf_(bf1(*(const bf16*)((const char*)P + (R * NP + COL_G + hk * 12 + (2 * (qb) + gl) * 3 + (br)) * 2u)))
    for (int i = lane; i < 8 * IMPP; i += 64) imp[(8 * w) * IMPP + i] = 0.f;

    f32x4 O[2][4];
#pragma unroll
    for (int qb = 0; qb < 2; ++qb)
#pragma unroll
        for (int db = 0; db < 4; ++db) O[qb][db] = (f32x4){0.f, 0.f, 0.f, 0.f};
    float mrow[2] = {-1e25f, -1e25f}, lrow[2] = {0.f, 0.f};
    int buf = 0;
    TileRegs tr;

    const int nct = (4 * c + 3 + 63) >> 6;
    tr = tile_load(KC, 64, VCT, 256, tid);
    for (int ti = 0; ti < nct; ++ti) {
        tile_store(lds, buf, tr, tid); __syncthreads();
        { const int nx = (ti + 1 < nct) ? ti + 1 : 0; tr = tile_load(KC + (size_t)nx * 64 * 64, 64, VCT + nx * 64, 256, tid); }
        if (16 * (64 * ti + 63) + 31 <= 64 * c) tile_compute<0, false>(lds, buf, 64 * ti, t, Qf, sl8, sl2, mrow, lrow, O, true, improw, 0, lane);
        else tile_compute<0, true>(lds, buf, 64 * ti, t, Qf, sl8, sl2, mrow, lrow, O, true, improw, 0, lane);
        buf ^= 1;
    }
#pragma unroll
    for (int qb = 0; qb < 2; ++qb) { float l = lrow[qb]; l += __shfl_xor(l, 16); l += __shfl_xor(l, 32); lrow[qb] = l > 0.f ? 1.0f / l : 0.f; }
    for (int ti = 0; ti < nct; ++ti) {
        tile_store(lds, buf, tr, tid); __syncthreads();
        if (ti + 1 < nct) tr = tile_load(KC + (size_t)(ti + 1) * 64 * 64, 64, VCT + (ti + 1) * 64, 256, tid);
        if (16 * (64 * ti + 63) + 31 <= 64 * c) tile_compute<1, false>(lds, buf, 64 * ti, t, Qf, sl8, sl2, mrow, lrow, O, true, improw, 16 * ti, lane);
        else tile_compute<1, true>(lds, buf, 64 * ti, t, Qf, sl8, sl2, mrow, lrow, O, true, improw, 16 * ti, lane);
        buf ^= 1;
    }
#pragma unroll
    for (int qb = 0; qb < 2; ++qb) { const float g0 = GATE(qb, 0);
#pragma unroll
        for (int db = 0; db < 4; ++db) {
#pragma unroll
            for (int e = 0; e < 4; ++e) outl[((qb * 4 + db) * 4 + e) * 512] = g0 * O[qb][db][e];
            O[qb][db] = (f32x4){0.f, 0.f, 0.f, 0.f}; } }

    unsigned long long wun = 0ull;
    for (int tt = 0; tt < 8; ++tt) {
        LAS unsigned* row = (LAS unsigned*)(imp + (8 * w + tt) * IMPP);
        unsigned key = ((row[lane] & ~63u) + 64u) | (unsigned)(63 - lane);
        if (lane == 0 || lane == c || lane == c - 1) key = 0x7f000000u | (unsigned)(63 - lane);
        if (lane > c) key = (unsigned)(63 - lane);
        row[lane] = key;
        int rank = 0;
#pragma unroll
        for (int i4 = 0; i4 < 16; ++i4) { const u32x4 v = *(const LAS u32x4*)(row + 4 * i4);
#pragma unroll
            for (int e = 0; e < 4; ++e) rank += (v[e] > key) ? 1 : 0; }
        const bool sel = (rank < 16) && (lane <= c);
        const unsigned long long mk = __ballot(sel);
        wun |= mk;
        if (lane == 0) { selm[(8 * w + tt) * 2] = (unsigned)mk; selm[(8 * w + tt) * 2 + 1] = (unsigned)(mk >> 32); }
    }
    if (lane == 0) { wunl[2 * w] = (unsigned)wun; wunl[2 * w + 1] = (unsigned)(wun >> 32); }
    const unsigned long long mysel = (unsigned long long)selm[tq * 2] | ((unsigned long long)selm[tq * 2 + 1] << 32);
    __syncthreads();
    unsigned long long uni = 0ull;
#pragma unroll
    for (int i = 0; i < 8; ++i) uni |= (unsigned long long)wunl[2 * i] | ((unsigned long long)wunl[2 * i + 1] << 32);
    uni = ((unsigned long long)__builtin_amdgcn_readfirstlane((unsigned)(uni >> 32)) << 32) | (unsigned long long)__builtin_amdgcn_readfirstlane((unsigned)uni);

    mrow[0] = mrow[1] = -1e25f; lrow[0] = lrow[1] = 0.f;
    {
        int j = __builtin_ctzll(uni);
        tr = tile_load(PKS + (size_t)(64 * j) * NP, NP, VTS + 64 * j, T, tid);
        while (uni) {
            j = __builtin_ctzll(uni); uni &= uni - 1;
            tile_store(lds, buf, tr, tid); __syncthreads();
            if (uni) { const int jn = __builtin_ctzll(uni); tr = tile_load(PKS + (size_t)(64 * jn) * NP, NP, VTS + 64 * jn, T, tid); }
            if ((wun >> j) & 1ull) { const bool sb = ((mysel >> j) & 1ull) != 0ull;
                if (j < c) tile_compute<2, false>(lds, buf, 64 * j, t, Qf, sl8, sl2, mrow, lrow, O, sb, improw, 0, lane);
                else tile_compute<2, true>(lds, buf, 64 * j, t, Qf, sl8, sl2, mrow, lrow, O, sb, improw, 0, lane); }
            buf ^= 1;
        }
    }
#pragma unroll
    for (int qb = 0; qb < 2; ++qb) { float l = lrow[qb]; l += __shfl_xor(l, 16); l += __shfl_xor(l, 32); const float inv = (l > 0.f ? 1.0f / l : 0.f) * GATE(qb, 1);
#pragma unroll
        for (int db = 0; db < 4; ++db) {
#pragma unroll
            for (int e = 0; e < 4; ++e) outl[((qb * 4 + db) * 4 + e) * 512] += inv * O[qb][db][e];
            O[qb][db] = (f32x4){0.f, 0.f, 0.f, 0.f}; } }

    mrow[0] = mrow[1] = -1e25f; lrow[0] = lrow[1] = 0.f;
    {
        const int j0 = c >= 8 ? c - 8 : 0;
        tr = tile_load(PKW + (size_t)(64 * j0) * NP, NP, VTW + 64 * j0, T, tid);
        for (int j = j0; j <= c; ++j) {
            tile_store(lds, buf, tr, tid); __syncthreads();
            if (j < c) tr = tile_load(PKW + (size_t)(64 * (j + 1)) * NP, NP, VTW + 64 * (j + 1), T, tid);
            if (j < c && j > c - 8) tile_compute<3, false>(lds, buf, 64 * j, t, Qf, sl8, sl2, mrow, lrow, O, true, improw, 0, lane);
            else tile_compute<3, true>(lds, buf, 64 * j, t, Qf, sl8, sl2, mrow, lrow, O, true, improw, 0, lane);
            buf ^= 1;
        }
    }
    float ss = 0.f;
    bf16* OA = (bf16*)(ws + WS_MIX);
#pragma unroll
    for (int qb = 0; qb < 2; ++qb) { float l = lrow[qb]; l += __shfl_xor(l, 16); l += __shfl_xor(l, 32); const float inv = (l > 0.f ? 1.0f / l : 0.f) * GATE(qb, 2);
#pragma unroll
        for (int db = 0; db < 4; ++db) { f32x4 o;
#pragma unroll
            for (int e = 0; e < 4; ++e) o[e] = outl[((qb * 4 + db) * 4 + e) * 512] + inv * O[qb][db][e];
            ss += (o.x * o.x + o.y * o.y) + (o.z * o.z + o.w * o.w);
            u32x2 pk; pk.x = pk2(o.x, o.y); pk.y = pk2(o.z, o.w);
            *(u32x2*)((char*)OA + (R * 1024 + hk * 256 + (2 * qb + gl) * 64 + 16 * db + 4 * kq) * 2u) = pk; } }
    ss += __shfl_xor(ss, 8); ss += __shfl_xor(ss, 16); ss += __shfl_xor(ss, 32);
    if (lane < 8) *(float*)(ws + WS_SSA + (R * 2 + hk) * 4u) = ss;
    __syncthreads();
#undef GATE
}


#define RLX_AGENT __ATOMIC_RELAXED, __HIP_MEMORY_SCOPE_AGENT
#define XB_TMO      128
#define XB_XCNT(j)  (256  + 64 * (j))
#define XB_XSUB(j)  (1280 + 64 * (j))
#define XB_XGEN(j)  (2304 + 64 * (j))
#define XB_TOP      3328
#define XB_TOPGEN   3392
#define XCD_BAR_WORDS 3456
#define XB_SPIN_CAP (1u << 18)

__device__ __forceinline__ unsigned xb_ld(unsigned* p)              { return __hip_atomic_load(p, __ATOMIC_RELAXED, __HIP_MEMORY_SCOPE_AGENT); }
__device__ __forceinline__ unsigned xb_add(unsigned* p, unsigned v) { return __hip_atomic_fetch_add(p, v, __ATOMIC_RELAXED, __HIP_MEMORY_SCOPE_AGENT); }
__device__ __forceinline__ unsigned xb_xcc_id() { return (unsigned)__builtin_amdgcn_s_getreg((3 << 11) | 20) & 0xFu; }
#define XB_SPIN(cond, bar) do { unsigned _sp = 0; while (cond) { __builtin_amdgcn_s_sleep(1); \
    if ((++_sp & 255u) == 0u) { if (xb_ld(&(bar)[XB_TMO])) break; if (_sp > XB_SPIN_CAP) { atomicAdd(&(bar)[XB_TMO], 1u); break; } } } } while (0)

struct XcdBarrier {
    unsigned* bar; unsigned x;
    volatile LAS unsigned* st;
};

__device__ __forceinline__ XcdBarrier xcd_barrier_post(unsigned* bar, volatile LAS unsigned* st) {
    XcdBarrier b; b.bar = bar; b.x = xb_xcc_id(); b.st = st;
    if (threadIdx.x == 0) (void)xb_add(&bar[XB_XCNT(b.x)], 1u);
    return b;
}
__device__ __forceinline__ void xcd_barrier_complete(unsigned* bar, unsigned x, unsigned& nloc, unsigned& nx) {
    const unsigned G = gridDim.x * gridDim.y * gridDim.z;
    unsigned sum, cnt, mine, sp = 0u;
    for (;;) {
        sum = 0u; cnt = 0u; mine = 0u;
#pragma unroll
        for (unsigned j = 0; j < 16; ++j) { const unsigned c = xb_ld(&bar[XB_XCNT(j)]); sum += c; cnt += (c > 0u) ? 1u : 0u; mine = (j == x) ? c : mine; }
        if (sum == G) break;
        __builtin_amdgcn_s_sleep(1);
        if ((++sp & 255u) == 0u) { if (xb_ld(&bar[XB_TMO])) break; if (sp > XB_SPIN_CAP) { atomicAdd(&bar[XB_TMO], 1u); break; } }
    }
    nloc = mine > 0u ? mine : 1u; nx = cnt > 0u ? cnt : 1u;
}

__device__ __forceinline__ void xcd_barrier(const XcdBarrier& b) {
    asm volatile("s_waitcnt vmcnt(0)" ::: "memory");
    __syncthreads();
    if (threadIdx.x == 0) {
        unsigned* bar = b.bar;
        __builtin_amdgcn_s_waitcnt(0);
        unsigned nloc = b.st[0], nx = b.st[1];
        if (nloc == 0u) { xcd_barrier_complete(bar, b.x, nloc, nx); b.st[0] = nloc; b.st[1] = nx; }
        const unsigned old = xb_add(&bar[XB_XSUB(b.x)], 1u);
        const unsigned gen = old / nloc;
        if (old + 1u == (gen + 1u) * nloc) {
            __builtin_amdgcn_fence(__ATOMIC_RELEASE, "agent");
            asm volatile("s_waitcnt vmcnt(0)" ::: "memory");
            const unsigned og = xb_add(&bar[XB_TOP], 1u);
            const unsigned tg = og / nx;
            if (og + 1u == (tg + 1u) * nx) xb_add(&bar[XB_TOPGEN], 1u);
            else XB_SPIN(xb_ld(&bar[XB_TOPGEN]) == tg, bar);
            __builtin_amdgcn_fence(__ATOMIC_ACQUIRE, "agent");
            xb_add(&bar[XB_XGEN(b.x)], 1u);
            asm volatile("s_waitcnt vmcnt(0)" ::: "memory");
        } else {
            XB_SPIN(xb_ld(&bar[XB_XGEN(b.x)]) == gen, bar);
            __builtin_amdgcn_fence(__ATOMIC_ACQUIRE, "agent");
            asm volatile("s_waitcnt vmcnt(0)" ::: "memory");
        }
    }
    __syncthreads();
}

constexpr int NPHASE = 11;
__global__ void __launch_bounds__(NWAVES * 64, 2) hymba_fwd(Args args) {
    extern __shared__ __attribute__((aligned(16))) unsigned char lds_raw[];
    LAS unsigned char* lds = (LAS unsigned char*)lds_raw;
    cg::grid_group grid = cg::this_grid();
    const int tid = threadIdx.x, lane = tid & 63, wave = __builtin_amdgcn_readfirstlane(tid >> 6);
    const int G = gridDim.x, bx = blockIdx.x;
    const int gw = bx * NWAVES + wave, NGW = G * NWAVES;
    unsigned char* ws = args.ws;
    const int lo = args.ph_lo, hi = args.ph_hi;
#define IN(k) (lo <= (k) && (k) < hi)
    if (tid < 16) ((LAS unsigned*)(lds + BARLDS_OFF))[tid] = 0u;
    __syncthreads();
    XcdBarrier bar = xcd_barrier_post((unsigned*)(ws + WS_CTL) + CW_BAR, (volatile LAS unsigned*)(lds + BARLDS_OFF));
    if (lo < 0) grid.sync();
#define SEAM(k) do { if (IN(k) && IN((k) + 1)) xcd_barrier(bar); } while (0)

    if (IN(0)) {
        LAS float* scr = (LAS float*)(lds + wave * 16384);
        constexpr int I_IN = 16 * 96, I_OUT = 16 * 32, I_G = 16 * 88, I_DN = 44 * 32, I_C1 = 32 * 4;
        constexpr int NITEMS = I_IN + I_OUT + 2 * I_G + I_DN + 2 * I_C1;
        for (int it = gw; it < NITEMS; it += NGW) {
            int r = it;
            if (r < I_IN) { p0_transpose_item(args.in[2], D, NPROJ, (bf16*)(ws + WS_WIN), 0, scr, r, 96, lane); continue; } r -= I_IN;
            if (r < I_OUT) { p0_transpose_item(args.in[12], D, D, (bf16*)(ws + WS_WOUT), 0, scr, r, 32, lane, args.in[10], 512); continue; } r -= I_OUT;
            if (r < I_G) { const int n0 = 32 * (r % 88); p0_transpose_item(args.in[14], D, DFF, (bf16*)(ws + WS_WGU), 256 * (n0 >> 7) + (n0 & 127) - n0, scr, r, 88, lane); continue; } r -= I_G;
            if (r < I_G) { const int n0 = 32 * (r % 88); p0_transpose_item(args.in[15], D, DFF, (bf16*)(ws + WS_WGU), 256 * (n0 >> 7) + 128 + (n0 & 127) - n0, scr, r, 88, lane); continue; } r -= I_G;
            if (r < I_DN) { p0_transpose_item(args.in[18], DFF, D, (bf16*)(ws + WS_WDN), 0, scr, r, 32, lane); continue; } r -= I_DN;
            if (r < I_C1) { p0_transpose_item(args.in[4], 2048, 128, (bf16*)(ws + WS_WC1K), 0, scr, r, 4, lane); continue; } r -= I_C1;
            p0_transpose_item(args.in[7], 2048, 128, (bf16*)(ws + WS_WC1V), 0, scr, r, 4, lane);
        }
        if (gw < 256) {
            const int kv = gw >> 7, n = gw & 127; const float* pos = args.in[kv ? 6 : 3]; const float* w1 = args.in[kv ? 7 : 4]; float s = 0.f;
#pragma unroll 8
            for (int k = lane; k < 2048; k += 64) s += pos[k] * w1[(size_t)k * 128 + n];
            s = wave_sum(s);
            if (lane == 0) ((float*)(ws + WS_CB))[gw] = s;
        }
        for (int m = gw; m < M; m += 2 * NGW) rms_row2_bf16(args.in[0] + (size_t)m * D, args.in[0] + (size_t)(m + NGW) * D, args.in[1], (bf16*)(ws + WS_XN) + (size_t)m * D, (bf16*)(ws + WS_XN) + (size_t)(m + NGW) * D, lane);
    }
    SEAM(0);
    if (IN(1)) {
        pg8::Gemm g{(const pg8::bf16_t*)(ws + WS_XN), (const pg8::bf16_t*)(ws + WS_WIN), M, NP, D}; pg8::StaticOrder S; S.init(M, NP, G, bx);
        pg8::EpiBf16 E{(pg8::bf16_t*)(ws + WS_P), NP, 0, 0};
        pg8::gemm_phase<pg8::EpiBf16, pg8::StaticOrder, true, true>(lds, g, S, E);
    }
    SEAM(1);
    if (IN(2)) {
        for (int it = bx; it < 256; it += G) compress_item(args, lds, it, tid);
        for (int it = bx; it < 2048; it += G) vtrans_item(args, lds, it, tid);
        for (int m = gw; m < M; m += NGW) conv_row(args, m, lane);
    }
    SEAM(2);
    if (IN(3)) {
        LAS int* ctl = (LAS int*)(lds + AL_CTL);
        for (;;) {
            if (tid == 0) ctl[0] = (int)atomicAdd((unsigned*)(ws + WS_CTL), 1u);
            __syncthreads();
            const int it = ctl[0];
            if (it >= 1024) break;
            attn_item(args, lds, it, tid);
        }
    }
    SEAM(3);
    if (IN(5)) {
        pg8::Gemm g{(const pg8::bf16_t*)(ws + WS_MIX), (const pg8::bf16_t*)(ws + WS_WOUT), M, D, D}; pg8::StaticOrder S; S.init(M, D, G, bx);
        pg8::EpiResF32Mid E{args.in[0], args.out, D, (const float*)(ws + WS_SSA), 1.f / 512.f, EPS};
        pg8::gemm_phase<pg8::EpiResF32Mid, pg8::StaticOrder, true, true>(lds, g, S, E);
    }
    SEAM(5);
    if (IN(6)) {
        for (int m = gw; m < M; m += 2 * NGW) rms_row2_bf16(args.out + (size_t)m * D, args.out + (size_t)(m + NGW) * D, args.in[13], (bf16*)(ws + WS_XN) + (size_t)m * D, (bf16*)(ws + WS_XN) + (size_t)(m + NGW) * D, lane);
    }
    SEAM(6);
    if (IN(7)) {
        constexpr int NMT = (M + 251) / 252;
        pg8::Gemm g{(const pg8::bf16_t*)(ws + WS_XN), (const pg8::bf16_t*)(ws + WS_WGU), NMT * 256, NGU, D}; pg8::StaticOrder S; S.init(NMT * 256, NGU, G, bx);
        pg8::EpiFfn E{(pg8::bf16_t*)(ws + WS_ACT), args.in[16], args.in[17], M, DFF, T};
        pg8::gemm_phase<pg8::EpiFfn, pg8::StaticOrder, true, true, true>(lds, g, S, E);
    }
    SEAM(7);
    if (IN(9)) {
        pg8::Gemm g{(const pg8::bf16_t*)(ws + WS_ACT), (const pg8::bf16_t*)(ws + WS_WDN), M, D, DFF}; pg8::StaticOrder S; S.init(M, D, G, bx);
        pg8::EpiResF32 E{args.out, args.out, D};
        pg8::gemm_phase<pg8::EpiResF32, pg8::StaticOrder, true, true>(lds, g, S, E);
    }
    SEAM(9);
    if (IN(10)) {
        const float* gn = args.in[19];
        for (int m = gw; m < M; m += 2 * NGW) {
            f32x4* xr = (f32x4*)(args.out + (size_t)m * D) + lane; f32x4* yr = (f32x4*)(args.out + (size_t)(m + NGW) * D) + lane; const f32x4* gr = (const f32x4*)gn + lane;
            f32x4 v[4], u[4]; float s = 0.f, q = 0.f;
#pragma unroll
            for (int j = 0; j < 4; ++j) { v[j] = xr[64 * j]; u[j] = yr[64 * j]; }
#pragma unroll
            for (int j = 0; j < 4; ++j) { s += (v[j].x * v[j].x + v[j].y * v[j].y) + (v[j].z * v[j].z + v[j].w * v[j].w); q += (u[j].x * u[j].x + u[j].y * u[j].y) + (u[j].z * u[j].z + u[j].w * u[j].w); }
            const float rs = 1.0f / sqrtf(wave_sum(s) * (1.f / D) + EPS), rq = 1.0f / sqrtf(wave_sum(q) * (1.f / D) + EPS);
#pragma unroll
            for (int j = 0; j < 4; ++j) { const f32x4 gg = gr[64 * j]; xr[64 * j] = v[j] * rs * gg; yr[64 * j] = u[j] * rq * gg; }
        }
    }
#undef IN
#undef SEAM
}

extern "C" void kernel_launch(void* const* d_in, const int* in_sizes, int n_in, void* d_out, int out_size, void* d_ws, size_t ws_size, hipStream_t stream) {
    static int grid = 0;
    if (grid == 0) {
        if (n_in != 20 || in_sizes[0] != M * D || out_size != M * D || ws_size < WS_END) { fprintf(stderr, "kernel_launch: unexpected sizes n_in %d in0 %d out %d ws %zu\n", n_in, n_in > 0 ? in_sizes[0] : -1, out_size, ws_size); grid = -1; return; }
        int dev = 0, cus = 0, per_cu = 0;
        hipGetDevice(&dev); hipDeviceGetAttribute(&cus, hipDeviceAttributeMultiprocessorCount, dev);
        if (hipFuncSetAttribute((const void*)hymba_fwd, hipFuncAttributeMaxDynamicSharedMemorySize, LDS_BYTES) != hipSuccess) { fprintf(stderr, "kernel_launch: hipFuncSetAttribute failed\n"); grid = -1; return; }
        if (hipOccupancyMaxActiveBlocksPerMultiprocessor(&per_cu, (const void*)hymba_fwd, NWAVES * 64, LDS_BYTES) != hipSuccess || per_cu < 1) { fprintf(stderr, "kernel_launch: occupancy query says %d\n", per_cu); per_cu = 1; }
        (void)hipGetLastError();
        grid = cus * per_cu;
        if (M % (2 * grid * NWAVES) != 0) { fprintf(stderr, "kernel_launch: grid %d does not divide the row passes\n", grid); grid = -1; return; }
    }
    if (grid < 0) return;
    if (hipMemsetAsync((char*)d_ws + WS_CTL, 0, CTL_ZERO_BYTES, stream) != hipSuccess) { fprintf(stderr, "kernel_launch: memset failed\n"); return; }
    Args a{};
    for (int i = 0; i < 20; ++i) a.in[i] = (const float*)d_in[i];
    a.out = (float*)d_out; a.ws = (unsigned char*)d_ws;
#if MK_N_LAUNCHES == 1
    a.ph_lo = 0; a.ph_hi = NPHASE;
    void* kargs[] = {&a};
    hipError_t e = hipLaunchCooperativeKernel((const void*)hymba_fwd, dim3(grid), dim3(NWAVES * 64), kargs, LDS_BYTES, stream);
    if (e != hipSuccess) fprintf(stderr, "cooperative launch failed: %s (grid %d)\n", hipGetErrorString(e), grid);
#else
    for (int p = 0; p < NPHASE; ++p) { a.ph_lo = p; a.ph_hi = p + 1; hipLaunchKernelGGL(hymba_fwd, dim3(grid), dim3(NWAVES * 64), LDS_BYTES, stream, a); }
#endif
}
```
